# Optimizing an MI355X kernel written in HIP

```python
import math
import jax, jax.numpy as jnp
from jax import lax
import numpy as np

D_MODEL = 2048
BATCH = 4
SEQ = 4096
DEPTH = 2

N_HEADS = 32
N_KV_HEADS = 4
HEAD_DIM = D_MODEL // N_HEADS
GROUP = N_HEADS // N_KV_HEADS
Q_DIM = N_HEADS * HEAD_DIM
KV_DIM = N_KV_HEADS * HEAD_DIM
D_FF = 4 * D_MODEL
WINDOW = 128
MOBA_BLOCK = 256
MOBA_TOPK = 3
MOBA_Q_CHUNK = 16
N_A_LAYERS = (DEPTH + 1) // 2
N_B_LAYERS = DEPTH - N_A_LAYERS
RMS_EPS = 1e-6
NEG_INF = -1e30

kernel_name = "yoco_swa_sink_moba_hybrid"


def rmsnorm(x, g):
    xf = x.astype(jnp.float32)
    y = xf * lax.rsqrt(jnp.mean(xf * xf, axis=-1, keepdims=True) + RMS_EPS)
    return (y * g.astype(jnp.float32)).astype(x.dtype)


def alibi_slopes(n):
    return jnp.exp2(-8.0 * jnp.arange(1, n + 1, dtype=jnp.float32) / n)


def sq_relu_mlp(x, w_up, w_down):
    h = jax.nn.relu(x @ w_up)
    return (h * h) @ w_down


def sliding_window_sink_attention(q, k, v, sinks, slopes):
    B, T, H, dh = q.shape
    nb = T // WINDOW
    qb = q.reshape(B, nb, WINDOW, N_KV_HEADS, GROUP, dh)
    kb = k.reshape(B, nb, WINDOW, N_KV_HEADS, dh)
    vb = v.reshape(B, nb, WINDOW, N_KV_HEADS, dh)

    def with_prev(a):
        prev = jnp.concatenate([jnp.zeros_like(a[:, :1]), a[:, :-1]], axis=1)
        return jnp.concatenate([prev, a], axis=2)

    kk, vv = with_prev(kb), with_prev(vb)
    s = jnp.einsum('bnqkgd,bnskd->bkgnqs', qb, kk).astype(jnp.float32) * (1.0 / math.sqrt(dh))
    qi = jnp.arange(WINDOW)[:, None] + WINDOW
    si = jnp.arange(2 * WINDOW)[None, :]
    dist = qi - si
    band = (dist >= 0) & (dist < WINDOW)
    n_idx = jnp.arange(nb)[:, None, None]
    mask = band[None] & ((n_idx > 0) | (si[None] >= WINDOW))
    bias = -slopes[:, :, None, None, None] * dist.astype(jnp.float32)[None, None, None]
    s = jnp.where(mask, s + bias, NEG_INF)
    sink = jnp.broadcast_to(sinks.astype(jnp.float32).reshape(N_KV_HEADS, GROUP, 1, 1, 1),
                            s.shape[:-1] + (1,))
    p = jax.nn.softmax(jnp.concatenate([s, sink], axis=-1), axis=-1)[..., :-1]
    o = jnp.einsum('bkgnqs,bnskd->bnqkgd', p.astype(v.dtype), vv)
    return o.reshape(B, T, H * dh)


def moba_shared_kv_side(x, kv_norm, w_kv_shared):
    B, T, _ = x.shape
    kv = rmsnorm(x, kv_norm) @ w_kv_shared
    k, v = jnp.split(kv, [KV_DIM], axis=-1)
    nblk = -(-T // MOBA_BLOCK)
    pad = nblk * MOBA_BLOCK - T

    def blocks(a):
        a = jnp.pad(a.reshape(B, T, N_KV_HEADS, HEAD_DIM), ((0, 0), (0, pad), (0, 0), (0, 0)))
        return a.reshape(B, nblk, MOBA_BLOCK, N_KV_HEADS, HEAD_DIM).transpose(0, 3, 1, 2, 4)

    kblk, vblk = blocks(k), blocks(v)
    counts = jnp.clip(T - jnp.arange(nblk) * MOBA_BLOCK, 1, MOBA_BLOCK).astype(jnp.float32)
    kmean = (kblk.astype(jnp.float32).sum(axis=3) / counts[:, None]).astype(k.dtype)
    return kblk, vblk, kmean


def moba_attention(q, kblk, vblk, kmean, slopes):
    B, T, H, dh = q.shape
    nblk = kblk.shape[2]
    ks = min(MOBA_TOPK, nblk)
    scale = 1.0 / math.sqrt(dh)
    q5 = q.reshape(B, T, N_KV_HEADS, GROUP, dh)
    gate = jnp.einsum('btkgd,bknd->bkgtn', q5, kmean).astype(jnp.float32)
    qblock = jnp.arange(T) // MOBA_BLOCK
    past = jnp.arange(nblk)[None, :] < qblock[:, None]
    gate = jnp.where(past, gate, NEG_INF)
    _, idx = lax.top_k(gate, ks)
    valid = idx < qblock[:, None]

    nc = T // MOBA_Q_CHUNK
    q_c = q5.reshape(B, nc, MOBA_Q_CHUNK, N_KV_HEADS, GROUP, dh).transpose(1, 0, 3, 4, 2, 5)
    idx_c = jnp.moveaxis(idx.reshape(B, N_KV_HEADS, GROUP, nc, MOBA_Q_CHUNK, ks), 3, 0)
    val_c = jnp.moveaxis(valid.reshape(B, N_KV_HEADS, GROUP, nc, MOBA_Q_CHUNK, ks), 3, 0)
    t0s = jnp.arange(nc, dtype=jnp.int32) * MOBA_Q_CHUNK
    b_ix = jnp.arange(B)[:, None, None, None, None]
    kv_ix = jnp.arange(N_KV_HEADS)[None, :, None, None, None]
    slopes4 = slopes[:, :, None, None]
    slopes5 = slopes[:, :, None, None, None]
    blk_pos = jnp.arange(MOBA_BLOCK)

    def step(args):
        qc, ic, vc, t0 = args
        pos_t = t0 + jnp.arange(MOBA_Q_CHUNK)
        k_sel = kblk[b_ix, kv_ix, ic]
        v_sel = vblk[b_ix, kv_ix, ic]
        s_sel = jnp.einsum('bkgqd,bkgqjsd->bkgqjs', qc, k_sel).astype(jnp.float32) * scale
        dist_sel = (pos_t[:, None, None] - (ic[..., None] * MOBA_BLOCK + blk_pos)).astype(jnp.float32)
        s_sel = jnp.where(vc[..., None], s_sel - slopes5 * dist_sel, NEG_INF)
        s_sel = s_sel.reshape(B, N_KV_HEADS, GROUP, MOBA_Q_CHUNK, ks * MOBA_BLOCK)
        j0 = t0 // MOBA_BLOCK
        k_own = lax.dynamic_index_in_dim(kblk, j0, axis=2, keepdims=False)
        v_own = lax.dynamic_index_in_dim(vblk, j0, axis=2, keepdims=False)
        dist_own = pos_t[:, None] - (j0 * MOBA_BLOCK + blk_pos)[None, :]
        s_own = jnp.einsum('bkgqd,bksd->bkgqs', qc, k_own).astype(jnp.float32) * scale
        s_own = jnp.where(dist_own >= 0, s_own - slopes4 * dist_own.astype(jnp.float32), NEG_INF)
        p = jax.nn.softmax(jnp.concatenate([s_sel, s_own], axis=-1), axis=-1).astype(vblk.dtype)
        p_sel = p[..., :ks * MOBA_BLOCK].reshape(B, N_KV_HEADS, GROUP, MOBA_Q_CHUNK, ks, MOBA_BLOCK)
        p_own = p[..., ks * MOBA_BLOCK:]
        return (jnp.einsum('bkgqjs,bkgqjsd->bkgqd', p_sel, v_sel)
                + jnp.einsum('bkgqs,bksd->bkgqd', p_own, v_own))

    o = lax.map(step, (q_c, idx_c, val_c, t0s))
    return o.transpose(1, 0, 4, 2, 3, 5).reshape(B, T, H * dh)


def setup_inputs(seed: int = 0) -> dict:
    key = jax.random.key(seed)
    ks = jax.random.split(key, 16)
    f32 = jnp.float32

    def w(k, shape, fan_in):
        return jax.random.normal(k, shape, f32) * (fan_in ** -0.5)

    def gain(k, shape):
        return 1.0 + 0.05 * jax.random.normal(k, shape, f32)

    return {
        "x": jax.random.normal(ks[0], (BATCH, SEQ, D_MODEL), f32),
        "w_qkv_a": w(ks[1], (N_A_LAYERS, D_MODEL, Q_DIM + 2 * KV_DIM), D_MODEL),
        "sinks_a": 0.5 * jax.random.normal(ks[2], (N_A_LAYERS, N_HEADS), f32),
        "w_o_a": w(ks[3], (N_A_LAYERS, Q_DIM, D_MODEL), Q_DIM),
        "kv_norm": gain(ks[4], (D_MODEL,)),
        "w_kv_shared": w(ks[5], (D_MODEL, 2 * KV_DIM), D_MODEL),
        "w_q_b": w(ks[6], (N_B_LAYERS, D_MODEL, Q_DIM), D_MODEL),
        "w_o_b": w(ks[7], (N_B_LAYERS, Q_DIM, D_MODEL), Q_DIM),
        "norm_attn_pre": gain(ks[8], (DEPTH, D_MODEL)),
        "norm_attn_post": gain(ks[9], (DEPTH, D_MODEL)),
        "norm_mlp_pre": gain(ks[10], (DEPTH, D_MODEL)),
        "norm_mlp_post": gain(ks[11], (DEPTH, D_MODEL)),
        "w_up": w(ks[12], (DEPTH, D_MODEL, D_FF), D_MODEL),
        "w_down": w(ks[13], (DEPTH, D_FF, D_MODEL), D_FF),
    }


def reference(x, w_qkv_a, sinks_a, w_o_a, kv_norm, w_kv_shared, w_q_b, w_o_b,
              norm_attn_pre, norm_attn_post, norm_mlp_pre, norm_mlp_post, w_up, w_down):
    B, T, _ = x.shape
    slopes = alibi_slopes(N_HEADS).reshape(N_KV_HEADS, GROUP)
    shared = None
    for l in range(DEPTH):
        h = rmsnorm(x, norm_attn_pre[l])
        if l < N_A_LAYERS:
            qkv = h @ w_qkv_a[l]
            q, k, v = jnp.split(qkv, [Q_DIM, Q_DIM + KV_DIM], axis=-1)
            mix = sliding_window_sink_attention(
                q.reshape(B, T, N_HEADS, HEAD_DIM),
                k.reshape(B, T, N_KV_HEADS, HEAD_DIM),
                v.reshape(B, T, N_KV_HEADS, HEAD_DIM),
                sinks_a[l], slopes) @ w_o_a[l]
        else:
            j = l - N_A_LAYERS
            q = (h @ w_q_b[j]).reshape(B, T, N_HEADS, HEAD_DIM)
            kblk, vblk, kmean = shared
            mix = moba_attention(q, kblk, vblk, kmean, slopes) @ w_o_b[j]
        x = x + rmsnorm(mix, norm_attn_post[l])
        h = rmsnorm(x, norm_mlp_pre[l])
        x = x + rmsnorm(sq_relu_mlp(h, w_up[l], w_down[l]), norm_mlp_post[l])
        if l == N_A_LAYERS - 1:
            shared = moba_shared_kv_side(x, kv_norm, w_kv_shared)
    return x
```

```cpp
#include <hip/hip_runtime.h>
#include <cstdio>
#include <cstdint>
#ifndef V_ST8
#define V_ST8 1
#endif
#ifndef AT_VTR
#define AT_VTR 0
#endif
#ifndef QO_BLK
#define QO_BLK 1
#endif
#ifndef PG8_WT
#define PG8_WT 0
#endif
#ifndef PG8_SLACK
#define PG8_SLACK 0
#endif
#ifndef PG8_B_AUX
#define PG8_B_AUX 0
#endif
#ifndef PG8_H_NT
#define PG8_H_NT 0
#endif
namespace pg8 {
#define PG8_LAS __attribute__((address_space(3)))
typedef unsigned short bf16_t;
typedef short bf16x8 __attribute__((ext_vector_type(8)));
typedef float f32x4 __attribute__((ext_vector_type(4)));
typedef unsigned u32x4 __attribute__((ext_vector_type(4)));
__device__ __forceinline__ int lane_now() { int l; asm volatile("v_mbcnt_lo_u32_b32 %0, -1, 0\n\tv_mbcnt_hi_u32_b32 %0, -1, %0" : "=v"(l)); return l; }
__device__ __forceinline__ int wave_tid(int wave) { return (wave << 6) | lane_now(); }
constexpr int BM = 256, BK = 64, HALF = 128, HTB = HALF * BK * 2  , STAGE_BYTES = 8 * HTB, NXCD = 8, WGM = 8;

__host__ __device__ __forceinline__ int lds_byte(int r, int c) { const int st = (r >> 4) * 2 + (c >> 5), rr = r & 15, cc = c & 31, ob = rr * 64 + cc * 2; return st * 1024 + (ob ^ (((ob >> 9) & 1) << 5)); }
__host__ __device__ __forceinline__ void stage_rc(int b, int& R, int& C) { const int st = b / 1024, sb = b % 1024, swz = sb ^ (((sb >> 9) & 1) << 5); R = (st >> 1) * 16 + swz / 64; C = (st & 1) * 32 + (swz % 64) / 2; }
__host__ __device__ __forceinline__ int perm32(int rho) { const int n = rho >> 4, i = rho & 15; return 8 * (i >> 2) + 4 * n + (i & 3); }

struct Unit { int pm, pn, ui; };
struct Gemm { const bf16_t* A; const bf16_t* Bt; int M, N, K; };

struct StaticOrder {
    int nM, nN, nwg, G, c;
    __host__ __device__ void init(int M, int N, int G_, int c_) { nM = M / BM; nN = N / BM; nwg = nM * nN; G = G_; c = c_; }
    __host__ __device__ bool next(int i, Unit& u) const {
        const long L = (long)i * G + c; if (L >= nwg) return false;
        int wgid = (int)L; { const int q = nwg / NXCD, r = nwg % NXCD, xcd = wgid % NXCD, off = wgid / NXCD; wgid = (xcd < r ? xcd * (q + 1) : r * (q + 1) + (xcd - r) * q) + off; }
        const int nig = WGM * nN, gid = wgid / nig, fm = gid * WGM, gsz = (nM - fm) < WGM ? (nM - fm) : WGM;
        u.pm = fm + ((wgid % nig) % gsz); u.pn = (wgid % nig) / gsz; u.ui = i; return true;
    }
    __device__ __forceinline__ void a_ready(const Unit&) const {}
    __device__ __forceinline__ void done(const Unit&) const {}
};

struct SameTileOrder { StaticOrder S; __host__ __device__ void init(int M, int N, int G_, int c_) { S.init(M, N, G_, c_); }
    __host__ __device__ bool next(int i, Unit& u) const { const bool ok = S.next(i, u); u.pm = 0; u.pn = 0; return ok; }
    __device__ __forceinline__ void a_ready(const Unit&) const {} __device__ __forceinline__ void done(const Unit&) const {} };
__device__ __forceinline__ unsigned cvt_pk_bf16(float lo, float hi) { unsigned r; asm volatile("v_cvt_pk_bf16_f32 %0, %1, %2" : "=v"(r) : "v"(lo), "v"(hi)); return r; }
#if PG8_WT
#define PG8_ST16(p_, v_) asm volatile("global_store_dwordx4 %0, %1, off sc1\n\ts_nop 1" :: "v"(p_), "v"(v_) : "memory")
#else
#define PG8_ST16(p_, v_) (*(u32x4*)(p_) = (v_))
#endif
__device__ __forceinline__ unsigned pk_fp8x4(float a, float b, float c, float d) {
    a = __builtin_fminf(__builtin_fmaxf(a, -448.f), 448.f); b = __builtin_fminf(__builtin_fmaxf(b, -448.f), 448.f); c = __builtin_fminf(__builtin_fmaxf(c, -448.f), 448.f); d = __builtin_fminf(__builtin_fmaxf(d, -448.f), 448.f);
    int w = 0; w = __builtin_amdgcn_cvt_pk_fp8_f32(a, b, w, false); w = __builtin_amdgcn_cvt_pk_fp8_f32(c, d, w, true); return (unsigned)w; }
constexpr float FP8_HSCALE = 16.0f, FP8_WSCALE = 256.0f;
template <int ACT  , bool NOSTORE = false  , int BLK = 0  , bool SAMEBLK = false  , bool LINEAR = false  > struct EpiBf16 {
    static constexpr bool PERM = true, AFTER_DRAIN = false; static constexpr int NST = NOSTORE ? 0 : 16;
    bf16_t* O; int ldc; const PG8_LAS float* rs; float cs; const unsigned* cmax; const PG8_LAS float* cml;
    __device__ __forceinline__ void operator()(const f32x4 (&acc)[2][2][4][2], const Unit& u, int wr, int wc, int fr_, int fq_) const {
        int fr = fr_, fq = fq_; asm volatile("" : "+v"(fr), "+v"(fq));
        const int row0 = u.pm * BM + wr * 64 + fr; const int col0 = u.pn * BM + wc * 32 + 8 * fq;
        float rsv[2][4];
#pragma unroll
        for (int ai = 0; ai < 2; ++ai)
#pragma unroll
            for (int m = 0; m < 4; ++m) rsv[ai][m] = rs ? rs[(u.ui & 7) * 256 + wr * 64 + fr + ai * HALF + m * 16] : 1.0f;
        f32x4 cv[2][2];
        if (cmax) {
#pragma unroll
            for (int bj = 0; bj < 2; ++bj)
#pragma unroll
                for (int n = 0; n < 2; ++n) {
                    if (cml) { cv[bj][n] = *(const PG8_LAS f32x4*)(cml + (u.ui & 7) * 256 + wc * 32 + 8 * fq + bj * HALF + 4 * n); continue; }
                    const u32x4 cw = *(const u32x4*)(cmax + col0 + bj * HALF + 4 * n);
                    cv[bj][n] = __builtin_bit_cast(f32x4, cw) * (1.0f / 127.0f); }
        }
#pragma unroll
        for (int ai = 0; ai < 2; ++ai)
#pragma unroll
            for (int m = 0; m < 4; ++m) { bf16_t* rowp = BLK == 2 ? O + (size_t)u.pm * 256 * ldc + ((u.pn * 4 + (wc >> 1)) * 32768 + ai * 16384 + ((wr * 4 + m) * 2 + (wc & 1)) * 1024 + ((fr * 64 + fq * 16) ^ ((fr >> 3) << 5))) / 2
                                        : BLK ? O + ((size_t)(u.pm * (ldc >> 8) + (SAMEBLK ? (u.pn & 3) : u.pn)) * 256 + wr * 64 + fr + ai * HALF + m * 16) * 256 + wc * 32 + 8 * fq : O + (size_t)(row0 + ai * HALF + m * 16) * ldc + col0;
                constexpr int BJSTEP = BLK == 2 ? 32768 : HALF;
#pragma unroll
                for (int bj = 0; bj < 2; ++bj) { f32x4 a0 = acc[ai][bj][m][0], a1 = acc[ai][bj][m][1];
                    if (cmax) { typedef int i32x4_ __attribute__((ext_vector_type(4)));
                        a0 = __builtin_convertvector(__builtin_bit_cast(i32x4_, acc[ai][bj][m][0]), f32x4) * cv[bj][0]; a1 = __builtin_convertvector(__builtin_bit_cast(i32x4_, acc[ai][bj][m][1]), f32x4) * cv[bj][1]; }
                    f32x4 v0 = a0 * (rsv[ai][m] * cs), v1 = a1 * (rsv[ai][m] * cs);
                    if (ACT == 3) {
#pragma unroll
                        for (int e = 0; e < 4; ++e) { const float a = fmaxf(v0[e], 0.f), b = fmaxf(v1[e], 0.f); v0[e] = a * a * FP8_HSCALE; v1[e] = b * b * FP8_HSCALE; }
                        typedef unsigned u32x2 __attribute__((ext_vector_type(2)));
                        u32x2 w8; w8.x = pk_fp8x4(v0[0], v0[1], v0[2], v0[3]); w8.y = pk_fp8x4(v1[0], v1[1], v1[2], v1[3]);
                        if (NOSTORE) { asm volatile("" :: "v"(w8)); continue; }
                        unsigned char* const p8 = BLK == 2 ? (unsigned char*)O + (size_t)u.pm * 256 * ldc + (u.pn * 2 + bj) * 32768 + ai * 16384 + ((wr * 4 + m) * 2 + (wc >> 1)) * 1024 + ((fr * 64 + (wc & 1) * 32 + fq * 8) ^ ((fr >> 3) << 5))
                                                  : BLK ? (unsigned char*)O + ((size_t)(u.pm * (ldc >> 8) + u.pn) * 256 + wr * 64 + fr + ai * HALF + m * 16) * 256 + wc * 32 + 8 * fq + bj * HALF
                                                      : (unsigned char*)O + (size_t)(row0 + ai * HALF + m * 16) * ldc + col0 + bj * HALF;
                        if (PG8_H_NT) __builtin_nontemporal_store(w8, (u32x2*)p8);
                        else *(u32x2*)p8 = w8;
                        continue; }
                    if (ACT == 2) {
#pragma unroll
                        for (int e = 0; e < 4; ++e) { const float a = fmaxf(v0[e], 0.f), b = fmaxf(v1[e], 0.f); v0[e] = a * a; v1[e] = b * b; } }
                    u32x4 w; w.x = cvt_pk_bf16(v0[0], v0[1]); w.y = cvt_pk_bf16(v0[2], v0[3]); w.z = cvt_pk_bf16(v1[0], v1[1]); w.w = cvt_pk_bf16(v1[2], v1[3]);
                    if (NOSTORE) { asm volatile("" :: "v"(w)); continue; }
                    if (LINEAR) { *(u32x4*)(O + (size_t)(u.pm * (ldc >> 8) + (SAMEBLK ? (u.pn & 3) : u.pn)) * 65536 + ((wr * 4 + wc) * 16 + (ai * 4 + m) * 2 + bj) * 512 + (fr + 16 * fq) * 8) = w; continue; }
                    if (ACT == 2 && PG8_H_NT) __builtin_nontemporal_store(w, (u32x4*)(rowp + bj * BJSTEP));
                    else PG8_ST16(rowp + bj * BJSTEP, w); } }
    }
};
struct EpiQKV {
    static constexpr bool PERM = true, AFTER_DRAIN = false; static constexpr int NST = 0;
    bf16_t* Q; bf16_t* Kb; float* kmbase; int layer; float qscale; const PG8_LAS float* rs;
    __device__ __forceinline__ void operator()(const f32x4 (&acc)[2][2][4][2], const Unit& u, int wr, int wc, int fr_, int fq_) const {
        int fr = fr_, fq = fq_; asm volatile("" : "+v"(fr), "+v"(fq));
        const int row0 = u.pm * BM + wr * 64 + fr;
        bf16_t* const Vt = Kb + (size_t)16384 * 256; float* const kmean = layer ? kmbase : nullptr; float* const kmaxp = kmbase + 64 * 256 + 64 * layer;
        float rsv[2][4];
#pragma unroll
        for (int ai = 0; ai < 2; ++ai)
#pragma unroll
            for (int m = 0; m < 4; ++m) rsv[ai][m] = rs[(u.ui & 7) * 256 + wr * 64 + fr + ai * HALF + m * 16];
        if (u.pn < 8) {
            const int col0 = u.pn * BM + wc * 32 + 8 * fq; const float sc = qscale;
#pragma unroll
            for (int ai = 0; ai < 2; ++ai)
#pragma unroll
                for (int m = 0; m < 4; ++m) { bf16_t* rowp = QO_BLK ? Q + ((size_t)(u.pm * 8 + u.pn) * 256 + wr * 64 + fr + ai * HALF + m * 16) * 256 + wc * 32 + 8 * fq : Q + (size_t)(row0 + ai * HALF + m * 16) * 2048 + col0;
#pragma unroll
                    for (int bj = 0; bj < 2; ++bj) { const float sr = sc * rsv[ai][m]; const f32x4 v0 = acc[ai][bj][m][0] * sr, v1 = acc[ai][bj][m][1] * sr;
                        u32x4 w; w.x = cvt_pk_bf16(v0[0], v0[1]); w.y = cvt_pk_bf16(v0[2], v0[3]); w.z = cvt_pk_bf16(v1[0], v1[1]); w.w = cvt_pk_bf16(v1[2], v1[3]);
                        PG8_ST16(rowp + bj * HALF, w); } }
        } else if (u.pn == 8) {
            const int col0 = wc * 32 + 8 * fq;
#pragma unroll
            for (int ai = 0; ai < 2; ++ai)
#pragma unroll
                for (int m = 0; m < 4; ++m) { bf16_t* rowp = Kb + (size_t)(row0 + ai * HALF + m * 16) * 256 + col0;
#pragma unroll
                    for (int bj = 0; bj < 2; ++bj) { const f32x4 v0 = acc[ai][bj][m][0] * rsv[ai][m], v1 = acc[ai][bj][m][1] * rsv[ai][m];
                        u32x4 w; w.x = cvt_pk_bf16(v0[0], v0[1]); w.y = cvt_pk_bf16(v0[2], v0[3]); w.z = cvt_pk_bf16(v1[0], v1[1]); w.w = cvt_pk_bf16(v1[2], v1[3]);
                        PG8_ST16(rowp + bj * HALF, w); } }
            __builtin_amdgcn_sched_barrier(0);
            {
#pragma unroll
                for (int bj = 0; bj < 2; ++bj) { float mx = 0.f;
#pragma unroll
                    for (int ai = 0; ai < 2; ++ai)
#pragma unroll
                        for (int m = 0; m < 4; ++m) { float ps = 0.f;
#pragma unroll
                            for (int n = 0; n < 2; ++n)
#pragma unroll
                                for (int e = 0; e < 4; ++e) { const float kv = acc[ai][bj][m][n][e] * rsv[ai][m]; ps = __builtin_fmaf(kv, kv, ps); }
                            ps += __shfl_xor(ps, 16); ps += __shfl_xor(ps, 32); mx = fmaxf(mx, ps); }
                    mx = fmaxf(mx, __shfl_xor(mx, 1)); mx = fmaxf(mx, __shfl_xor(mx, 2)); mx = fmaxf(mx, __shfl_xor(mx, 4)); mx = fmaxf(mx, __shfl_xor(mx, 8));
                    __builtin_amdgcn_sched_barrier(0);
                    if (fr == 0 && fq == 0) __hip_atomic_fetch_max((unsigned*)kmaxp + (((u.pm >> 4) * 4 + 2 * bj + (wc >> 1)) * 2 + (wc & 1)), __builtin_bit_cast(unsigned, mx), __ATOMIC_RELAXED, __HIP_MEMORY_SCOPE_AGENT); }
            }
            __builtin_amdgcn_sched_barrier(0);
            if (kmean) {
                float* km = kmean + (size_t)u.pm * 256 + col0;
#pragma unroll
                for (int bj = 0; bj < 2; ++bj)
#pragma unroll
                    for (int n = 0; n < 2; ++n)
#pragma unroll
                        for (int e = 0; e < 4; ++e) { float s = 0.f;
#pragma unroll
                            for (int ai = 0; ai < 2; ++ai)
#pragma unroll
                                for (int m = 0; m < 4; ++m) s += acc[ai][bj][m][n][e] * rsv[ai][m];
                            s += __shfl_xor(s, 1); s += __shfl_xor(s, 2); s += __shfl_xor(s, 4); s += __shfl_xor(s, 8);
                            if (fr == 0) __hip_atomic_fetch_add(km + bj * HALF + 4 * n + e, s, __ATOMIC_RELAXED, __HIP_MEMORY_SCOPE_AGENT);
                            __builtin_amdgcn_sched_barrier(0); }
            }
        } else if (AT_VTR) {
            const int col0 = wc * 32 + 8 * fq;
#pragma unroll
            for (int ai = 0; ai < 2; ++ai)
#pragma unroll
                for (int m = 0; m < 4; ++m) { bf16_t* rowp = Vt + (size_t)(row0 + ai * HALF + m * 16) * 256 + col0;
#pragma unroll
                    for (int bj = 0; bj < 2; ++bj) { const f32x4 v0 = acc[ai][bj][m][0] * rsv[ai][m], v1 = acc[ai][bj][m][1] * rsv[ai][m];
                        u32x4 w; w.x = cvt_pk_bf16(v0[0], v0[1]); w.y = cvt_pk_bf16(v0[2], v0[3]); w.z = cvt_pk_bf16(v1[0], v1[1]); w.w = cvt_pk_bf16(v1[2], v1[3]);
                        PG8_ST16(rowp + bj * HALF, w); } }
        } else {
            if (V_ST8) {
                const int b = u.pm >> 4, tb4 = (u.pm & 15) * 256 + wr * 64 + (fr & ~3);
                const bool odd = (fr & 1) != 0, hi2 = (fr & 2) != 0;
#pragma unroll
                for (int ai = 0; ai < 2; ++ai)
#pragma unroll
                    for (int m = 0; m < 4; ++m)
#pragma unroll
                        for (int bj = 0; bj < 2; ++bj)
#pragma unroll
                            for (int n = 0; n < 2; ++n) { const f32x4 v = acc[ai][bj][m][n] * rsv[ai][m];
                                const float s0 = odd ? v[0] : v[2], s1 = odd ? v[1] : v[3];
                                const float r0 = __shfl_xor(s0, 1), r1 = __shfl_xor(s1, 1);
                                const unsigned w0 = odd ? cvt_pk_bf16(r0, v[2]) : cvt_pk_bf16(v[0], r0);
                                const unsigned w1 = odd ? cvt_pk_bf16(r1, v[3]) : cvt_pk_bf16(v[1], r1);
                                const unsigned snd = hi2 ? w0 : w1, rcv = (unsigned)__shfl_xor((int)snd, 2);
                                typedef unsigned u32x2_ __attribute__((ext_vector_type(2)));
                                u32x2_ o; o.x = hi2 ? rcv : w0; o.y = hi2 ? w1 : rcv;
                                const int cl = bj * HALF + wc * 32 + 8 * fq + 4 * n + (odd ? 2 : 0) + (hi2 ? 1 : 0);
                                const int kvh = cl >> 6, d = cl & 63;
                                *(u32x2_*)(Vt + ((size_t)((b * 4 + kvh) * 64 + d)) * 4096 + tb4 + ai * HALF + m * 16) = o; }
            } else {
            const int b = u.pm >> 4, tb = (u.pm & 15) * 256 + wr * 64 + (fr & ~1);
            const bool odd = (fr & 1) != 0;
#pragma unroll
            for (int ai = 0; ai < 2; ++ai)
#pragma unroll
                for (int m = 0; m < 4; ++m)
#pragma unroll
                    for (int bj = 0; bj < 2; ++bj)
#pragma unroll
                        for (int n = 0; n < 2; ++n) { const f32x4 v = acc[ai][bj][m][n] * rsv[ai][m];
                            const float s0 = odd ? v[0] : v[2], s1 = odd ? v[1] : v[3];
                            const float r0 = __shfl_xor(s0, 1), r1 = __shfl_xor(s1, 1);
                            const int cl = bj * HALF + wc * 32 + 8 * fq + 4 * n + (odd ? 2 : 0);
                            const int kvh = cl >> 6, d = cl & 63;
                            unsigned* p = (unsigned*)(Vt + ((size_t)((b * 4 + kvh) * 64 + d)) * 4096 + tb + ai * HALF + m * 16);
                            const unsigned w0 = odd ? cvt_pk_bf16(r0, v[2]) : cvt_pk_bf16(v[0], r0);
                            const unsigned w1 = odd ? cvt_pk_bf16(r1, v[3]) : cvt_pk_bf16(v[1], r1);
                            p[0] = w0; p[2048] = w1; }
            }
        }
    }
};
struct EpiNull {
    static constexpr bool PERM = true, AFTER_DRAIN = false; static constexpr int NST = 0;
    __device__ __forceinline__ void operator()(const f32x4 (&acc)[2][2][4][2], const Unit& u, int wr, int wc, int fr_, int fq_) const {
#pragma unroll
        for (int ai = 0; ai < 2; ++ai)
#pragma unroll
            for (int bj = 0; bj < 2; ++bj)
#pragma unroll
                for (int m = 0; m < 4; ++m)
#pragma unroll
                    for (int n = 0; n < 2; ++n) asm volatile("" :: "v"(acc[ai][bj][m][n]));
    }
};
typedef int pg8_v8i __attribute__((ext_vector_type(8)));
typedef int pg8_v4i __attribute__((ext_vector_type(4)));
__device__ __forceinline__ pg8_v8i pg8_cat(bf16x8 a, bf16x8 b) { const pg8_v4i x = __builtin_bit_cast(pg8_v4i, a), y = __builtin_bit_cast(pg8_v4i, b); return (pg8_v8i){x[0], x[1], x[2], x[3], y[0], y[1], y[2], y[3]}; }
template <class Epi, class Sched, bool ALIGN_EPI = false, bool SP2 = false, bool FP8 = false, bool I8 = false, int ALAY = 0, bool BLIN = false, bool SLK = true>
__device__ __forceinline__ void gemm_phase(PG8_LAS unsigned char* lds, const Gemm g, const Sched& S, const Epi& E, const int wave_) {
    const int tid = wave_tid(wave_), wid = wave_, lane = tid & 63, wr = wid >> 2, wc = wid & 3, fr = lane & 15, fq = lane >> 4;
    const int K = g.K, nt = K / BK;
    unsigned voffA[2], voffB[2];
#pragma unroll
    for (int i = 0; i < 2; ++i) { int R, C; stage_rc(tid * 16 + i * 8192, R, C); const int Rb = Epi::PERM ? ((R & ~31) + perm32(R & 31)) : R;
        voffA[i] = ALAY < 0 ? (unsigned)(tid * 16 + i * 8192) : ALAY > 0 ? (unsigned)(R * ALAY + C * 2) : (unsigned)(R * K + C) * 2u;
        voffB[i] = BLIN ? (unsigned)(tid * 16 + i * 8192) : (unsigned)(Rb * K + C) * 2u; }
    const size_t tstep = (size_t)2 * HALF * K * 2;
    const size_t kstepA = ALAY < 0 ? (size_t)32768 : (size_t)(BK * 2), kstepB = BLIN ? (size_t)32768 : (size_t)(BK * 2);
    const size_t hstepA = ALAY < 0 ? (size_t)16384 : ALAY > 0 ? (size_t)HALF * ALAY : (size_t)HALF * K * 2, hstepB = BLIN ? (size_t)16384 : (size_t)HALF * K * 2;
#define PG8_KOFFA(t_) (ALAY > 0 ? (size_t)((t_) / (ALAY / 128)) * (size_t)(256 * ALAY) + (size_t)((t_) % (ALAY / 128)) * 128 : (size_t)(t_) * kstepA)
    const unsigned ldsw = (unsigned)wid * 1024u;
    const int aoff = lds_byte(wr * 64 + fr, fq * 8), boff = lds_byte(wc * 32 + fr, fq * 8);
#define PG8_SA(b, h) (((b) * 2 + (h)) * HTB)
#define PG8_SB(b, h) ((4 + (b) * 2 + (h)) * HTB)
#define PG8_STAGE(bufoff, gbase, voff) do { _Pragma("unroll") for (int _i = 0; _i < 2; ++_i) \
        __builtin_amdgcn_global_load_lds((const unsigned*)((const char*)(gbase) + (voff)[_i]), (PG8_LAS unsigned*)(lds + (bufoff) + ldsw + _i * 8192), 16, 0, 0); } while (0)
#define PG8_STAGEB(bufoff, gbase, voff) do { _Pragma("unroll") for (int _i = 0; _i < 2; ++_i) \
        __builtin_amdgcn_global_load_lds((const unsigned*)((const char*)(gbase) + (voff)[_i]), (PG8_LAS unsigned*)(lds + (bufoff) + ldsw + _i * 8192), 16, 0, PG8_B_AUX); } while (0)
#define PG8_LDA(dst, b, h) do { _Pragma("unroll") for (int m = 0; m < 4; ++m) _Pragma("unroll") for (int k = 0; k < 2; ++k) dst[m][k] = *(const PG8_LAS bf16x8*)(lds + PG8_SA(b, h) + aoff + m * 2048 + k * 1024); } while (0)
#define PG8_LDB(dst, b, h) do { _Pragma("unroll") for (int n = 0; n < 2; ++n) _Pragma("unroll") for (int k = 0; k < 2; ++k) dst[n][k] = *(const PG8_LAS bf16x8*)(lds + PG8_SB(b, h) + boff + n * 2048 + k * 1024); } while (0)
#define PG8_MMA(ai, bj, At, Bt) do { __builtin_amdgcn_s_setprio(1); _Pragma("unroll") for (int m = 0; m < 4; ++m) _Pragma("unroll") for (int n = 0; n < 2; ++n) { \
        if constexpr (FP8) { const pg8_v8i a8_ = pg8_cat(Bt[n][0], Bt[n][1]), b8_ = pg8_cat(At[m][0], At[m][1]); asm volatile("v_mfma_f32_16x16x128_f8f6f4 %0, %1, %2, %0" : "+v"(acc[ai][bj][m][n]) : "v"(a8_), "v"(b8_)); } \
        else if constexpr (I8) { _Pragma("unroll") for (int k = 0; k < 2; ++k) acc[ai][bj][m][n] = __builtin_bit_cast(f32x4, __builtin_amdgcn_mfma_i32_16x16x64_i8(__builtin_bit_cast(pg8_v4i, Bt[n][k]), __builtin_bit_cast(pg8_v4i, At[m][k]), __builtin_bit_cast(pg8_v4i, acc[ai][bj][m][n]), 0, 0, 0)); } \
        else { _Pragma("unroll") for (int k = 0; k < 2; ++k) acc[ai][bj][m][n] = __builtin_amdgcn_mfma_f32_16x16x32_bf16(Bt[n][k], At[m][k], acc[ai][bj][m][n], 0, 0, 0); } } __builtin_amdgcn_s_setprio(0); } while (0)
#define PG8_WAIT_V(n) asm volatile("s_waitcnt vmcnt(" #n ")" ::: "memory")
#define PG8_WAIT_L(n) asm volatile("s_waitcnt lgkmcnt(" #n ")" ::: "memory")
#define PG8_BAR __builtin_amdgcn_s_barrier()
#define PG8_SCHED __builtin_amdgcn_sched_barrier(0)
    Unit cur, nxt; int ui = 0;
    if (!S.next(0, cur)) return;
    f32x4 acc[2][2][4][2];
#pragma unroll
    for (int a = 0; a < 2; ++a)
#pragma unroll
        for (int b = 0; b < 2; ++b)
#pragma unroll
            for (int m = 0; m < 4; ++m)
#pragma unroll
                for (int n = 0; n < 2; ++n) acc[a][b][m][n] = (f32x4){0.f, 0.f, 0.f, 0.f};
    bf16x8 At[4][2], B0[2][2], B1[2][2];
    const char* cA = (const char*)g.A + (size_t)cur.pm * tstep; const char* cB = (const char*)g.Bt + (size_t)cur.pn * tstep;
    S.a_ready(cur);
    if constexpr (SP2) {
        PG8_STAGEB(PG8_SB(0, 0), cB, voffB); PG8_STAGEB(PG8_SB(0, 1), cB + hstepB, voffB); PG8_STAGE(PG8_SA(0, 0), cA, voffA); PG8_STAGE(PG8_SA(0, 1), cA + hstepA, voffA);
        if (wr == 1) PG8_BAR;
        PG8_WAIT_V(2); PG8_BAR;
        PG8_STAGEB(PG8_SB(1, 0), cB + kstepB, voffB); PG8_STAGE(PG8_SA(1, 0), cA + kstepA, voffA); PG8_STAGEB(PG8_SB(1, 1), cB + hstepB + kstepB, voffB);
        PG8_WAIT_V(6); PG8_BAR;
    } else {
        PG8_STAGEB(PG8_SB(0, 0), cB, voffB); PG8_STAGE(PG8_SA(0, 0), cA, voffA); PG8_STAGEB(PG8_SB(0, 1), cB + hstepB, voffB); PG8_STAGE(PG8_SA(0, 1), cA + hstepA, voffA);
        if (wr == 1) PG8_BAR;
        PG8_WAIT_V(4); PG8_BAR;
        PG8_STAGEB(PG8_SB(1, 0), cB + kstepB, voffB); PG8_STAGE(PG8_SA(1, 0), cA + kstepA, voffA); PG8_STAGEB(PG8_SB(1, 1), cB + hstepB + kstepB, voffB);
        PG8_WAIT_V(6); PG8_BAR;
    }
    for (;;) {
        const bool has_next = S.next(ui + 1, nxt);
        const char* nA = has_next ? (const char*)g.A + (size_t)nxt.pm * tstep : cA; const char* nB = has_next ? (const char*)g.Bt + (size_t)nxt.pn * tstep : cB;
#define PG8_SETUP_T() \
            const bool last = (t == nt - 2); \
            const char* a1 = cA + PG8_KOFFA(t + 1);                                                    \
            const char* a2 = last ? nA : cA + PG8_KOFFA(t + 2); const char* b2 = last ? nB : cB + (size_t)(t + 2) * kstepB;     \
            const char* a3 = a2 + kstepA; const char* b3 = b2 + kstepB;                              \
            if (last && has_next) S.a_ready(nxt);
#define PG8_WAIT_VS(SLK) do { if (SLK) PG8_WAIT_V(24); else PG8_WAIT_V(8); } while (0)
#define PG8_ITER_SP2(SLK) \
              \
              \
            PG8_LDB(B0, 0, 0); PG8_LDB(B1, 0, 1); PG8_SCHED; PG8_LDA(At, 0, 0); if (!(SLK)) PG8_STAGE(PG8_SA(1, 1), a1 + hstepA, voffA); \
            PG8_WAIT_VS(SLK); PG8_WAIT_L(0); PG8_BAR; PG8_MMA(0, 0, At, B0); PG8_MMA(0, 1, At, B1); PG8_BAR; PG8_SCHED; \
              \
            PG8_LDA(At, 0, 1); PG8_STAGEB(PG8_SB(0, 0), b2, voffB); PG8_STAGEB(PG8_SB(0, 1), b2 + hstepB, voffB); PG8_STAGE(PG8_SA(0, 0), a2, voffA); \
            PG8_WAIT_VS(SLK); PG8_WAIT_L(0); PG8_BAR; PG8_MMA(1, 0, At, B0); PG8_MMA(1, 1, At, B1); PG8_BAR; PG8_SCHED; \
              \
            PG8_LDB(B0, 1, 0); PG8_LDB(B1, 1, 1); PG8_SCHED; PG8_LDA(At, 1, 0); PG8_STAGE(PG8_SA(0, 1), a2 + hstepA, voffA); \
            PG8_WAIT_VS(SLK); PG8_WAIT_L(0); PG8_BAR; PG8_MMA(0, 0, At, B0); PG8_MMA(0, 1, At, B1); PG8_BAR; PG8_SCHED; \
              \
            PG8_LDA(At, 1, 1); PG8_STAGEB(PG8_SB(1, 0), b3, voffB); PG8_STAGEB(PG8_SB(1, 1), b3 + hstepB, voffB); PG8_STAGE(PG8_SA(1, 0), a3, voffA); \
            PG8_WAIT_V(8); PG8_WAIT_L(0); PG8_BAR; PG8_MMA(1, 0, At, B0); PG8_MMA(1, 1, At, B1); PG8_BAR; PG8_SCHED;
        constexpr bool SLACK_OK = PG8_SLACK && SLK && SP2 && ALIGN_EPI && Epi::NST >= 16;
        int t = 0;
        if constexpr (SLACK_OK) { if (ui > 0) { PG8_SETUP_T() PG8_ITER_SP2(1) t = 2; } }
        for (; t < nt; t += 2) {
            PG8_SETUP_T()
            if constexpr (SP2) {
            PG8_ITER_SP2(0)
            } else {
            PG8_LDB(B0, 0, 0); PG8_SCHED; PG8_LDA(At, 0, 0); PG8_STAGE(PG8_SA(1, 1), a1 + hstepA, voffA);
            PG8_WAIT_L(8); PG8_BAR; PG8_WAIT_L(0); PG8_MMA(0, 0, At, B0); PG8_BAR; PG8_SCHED;
            PG8_LDB(B1, 0, 1); PG8_STAGEB(PG8_SB(0, 0), b2, voffB);
            PG8_BAR; PG8_WAIT_L(0); PG8_MMA(0, 1, At, B1); PG8_BAR;
            PG8_LDA(At, 0, 1); PG8_STAGE(PG8_SA(0, 0), a2, voffA);
            PG8_BAR; PG8_WAIT_L(0); PG8_MMA(1, 0, At, B0); PG8_BAR; PG8_SCHED;
            PG8_STAGEB(PG8_SB(0, 1), b2 + hstepB, voffB);
            PG8_WAIT_V(6); PG8_BAR; PG8_MMA(1, 1, At, B1); PG8_BAR;
            PG8_LDB(B0, 1, 0); PG8_SCHED; PG8_LDA(At, 1, 0); PG8_STAGE(PG8_SA(0, 1), a2 + hstepA, voffA);
            PG8_WAIT_L(8); PG8_BAR; PG8_WAIT_L(0); PG8_MMA(0, 0, At, B0); PG8_BAR; PG8_SCHED;
            PG8_LDB(B1, 1, 1); PG8_STAGEB(PG8_SB(1, 0), b3, voffB);
            PG8_BAR; PG8_WAIT_L(0); PG8_MMA(0, 1, At, B1); PG8_BAR;
            PG8_LDA(At, 1, 1); PG8_STAGE(PG8_SA(1, 0), a3, voffA);
            PG8_BAR; PG8_WAIT_L(0); PG8_MMA(1, 0, At, B0); PG8_BAR; PG8_SCHED;
            PG8_STAGEB(PG8_SB(1, 1), b3 + hstepB, voffB);
            PG8_WAIT_V(6); PG8_BAR; PG8_MMA(1, 1, At, B1); PG8_BAR;
            }
        }
        if constexpr (FP8) asm volatile("s_nop 15\n\ts_nop 15" ::: "memory");
        if constexpr (ALIGN_EPI) { if (wr == 0) PG8_BAR; }
        if constexpr (SLACK_OK) { if (has_next) PG8_STAGE(PG8_SA(1, 1), nA + PG8_KOFFA(1) + hstepA, voffA); }
        if constexpr (!Epi::AFTER_DRAIN) { int t2 = wave_tid(0); asm volatile("" : "+v"(t2)); E(acc, cur, wr, wc, t2 & 15, (t2 >> 4) & 3); S.done(cur); }
        if (!has_next) break;
#pragma unroll
        for (int a = 0; a < 2; ++a)
#pragma unroll
            for (int b = 0; b < 2; ++b)
#pragma unroll
                for (int m = 0; m < 4; ++m)
#pragma unroll
                    for (int n = 0; n < 2; ++n) acc[a][b][m][n] = (f32x4){0.f, 0.f, 0.f, 0.f};
        cur = nxt; cA = nA; cB = nB; ++ui;
        if constexpr (ALIGN_EPI) { if (wr == 1) PG8_BAR; }
    }
    PG8_WAIT_V(0);
    if constexpr (!ALIGN_EPI) { if (wr == 0) PG8_BAR; }
    PG8_BAR;
    if constexpr (Epi::AFTER_DRAIN) { E.fused(acc, cur, wr, wc, fr, fq, lds, wid, lane); S.done(cur); }
#undef PG8_KOFFA
#undef PG8_SETUP_T
#undef PG8_WAIT_VS
#undef PG8_ITER_SP2
#undef PG8_SA
#undef PG8_SB
#undef PG8_STAGE
#undef PG8_STAGEB
#undef PG8_LDA
#undef PG8_LDB
#undef PG8_MMA
#undef PG8_WAIT_V
#undef PG8_WAIT_L
#undef PG8_BAR
#undef PG8_SCHED
}
}
#ifndef PG8_SP2
#define PG8_SP2 true
#endif
#ifndef H_BLK
#define H_BLK 2
#endif
#ifndef Y_BLK
#define Y_BLK 1
#endif
#ifndef W_LIN
#define W_LIN true
#endif
#ifndef PG8_ALIGN
#define PG8_ALIGN true
#endif
constexpr int NWAVES = 8;
#ifndef MK_N_LAUNCHES
#define MK_N_LAUNCHES 1
#endif
#ifndef FP8_DOWN1
#define FP8_DOWN1 1
#endif
#ifndef I8_UP1
#define I8_UP1 1
#endif
#ifndef I8_UP0
#define I8_UP0 1
#endif
#ifndef I8_TEST
#define I8_TEST 0
#endif
#ifndef SKEW_UP
#define SKEW_UP 0
#endif
#ifndef SKEW_QKV
#define SKEW_QKV 0
#endif
#ifndef SKEW_O
#define SKEW_O 0
#endif
#ifndef SKEW_DN
#define SKEW_DN 0
#endif
#ifndef PROBE_EXPT
#define PROBE_EXPT 0
#endif
#ifndef PROBE_DUP
#define PROBE_DUP 0
#endif
constexpr int N_PHASES = 15;
constexpr int N_LAUNCHES = MK_N_LAUNCHES;

constexpr int BATCH = 4, SEQ = 4096, D = 2048, NH = 32, NKV = 4, HD = 64, FF = 8192;
constexpr int M = BATCH * SEQ;
constexpr int NQKV = 2560;
constexpr float RMS_EPS = 1e-6f;
constexpr float LOG2E = 1.4426950408889634f;
constexpr float QSCALE = 0.125f * LOG2E;

constexpr size_t MiB = 1u << 20;
constexpr size_t WS_CTL = 0, CTL_ZERO_BYTES = 1 * MiB;
constexpr size_t WS_W = 1 * MiB;
constexpr size_t W_QKV = 10 * MiB, W_O = 8 * MiB, W_UP = 32 * MiB, W_DN = 32 * MiB, W_LAYER = W_QKV + W_O + W_UP + W_DN;
constexpr size_t WS_H = WS_W + 2 * W_LAYER;
constexpr size_t WS_QO = WS_H;
constexpr size_t WS_XN = WS_H + 256 * MiB;
constexpr size_t WS_K = WS_XN + 64 * MiB;
constexpr size_t WS_VT = WS_K + 8 * MiB;
constexpr size_t WS_RS = WS_VT + 8 * MiB;
constexpr size_t WS_END = WS_RS + 1 * MiB;
constexpr int CW_BAR = 4096;
constexpr size_t XQ_OFF = 64 * MiB;
constexpr size_t CTL_CMAX = 768 * 1024;
constexpr size_t CTL_KMEAN = 512 * 1024;

constexpr int RING_OFF = 0, RING_BYTES = 131072;
constexpr int LDSCTL_OFF = RING_BYTES, MISC_OFF = LDSCTL_OFF + 320;
constexpr int LDS_BYTES = 151552;
constexpr int RSL_OFF = MISC_OFF + 256;
constexpr int CML_OFF = RSL_OFF + 8 * 1024;
static_assert(RSL_OFF % 16 == 0 && CML_OFF + 8 * 1024 <= LDS_BYTES, "LDS map");

#define GAS __attribute__((address_space(1)))
#define LAS __attribute__((address_space(3)))
typedef unsigned short bf16;
typedef unsigned v4u __attribute__((ext_vector_type(4)));
typedef unsigned v2u __attribute__((ext_vector_type(2)));
typedef float f32x4 __attribute__((ext_vector_type(4)));
typedef float f32x16 __attribute__((ext_vector_type(16)));
typedef short bf16x8 __attribute__((ext_vector_type(8)));
typedef GAS unsigned gu32;
#define RLX_AGENT __ATOMIC_RELAXED, __HIP_MEMORY_SCOPE_AGENT
#define LDS_WAIT() asm volatile("s_waitcnt lgkmcnt(0)" ::: "memory")
#define VM_WAIT() asm volatile("s_waitcnt vmcnt(0)" ::: "memory")
__device__ __forceinline__ unsigned f2bf(float f) { unsigned u = __builtin_bit_cast(unsigned, f); return (u + 0x7fffu + ((u >> 16) & 1u)) >> 16; }
__device__ __forceinline__ unsigned pk2(float lo, float hi) { return f2bf(lo) | (f2bf(hi) << 16); }
__device__ __forceinline__ unsigned cvtpk(float lo, float hi) { unsigned r; asm volatile("v_cvt_pk_bf16_f32 %0, %1, %2" : "=v"(r) : "v"(lo), "v"(hi)); return r; }
__device__ __forceinline__ float bflo(unsigned w) { return __builtin_bit_cast(float, w << 16); }
__device__ __forceinline__ float bfhi(unsigned w) { return __builtin_bit_cast(float, w & 0xffff0000u); }
#define XB_TMO      128
#define XB_XCNT(j)  (256  + 64 * (j))
#define XB_XSUB(j)  (1280 + 64 * (j))
#define XB_XGEN(j)  (2304 + 64 * (j))
#define XB_TOP      3328
#define XB_TOPGEN   3392
#define XCD_BAR_WORDS 3456
#define XB_SPIN_CAP (1u << 18)

__device__ __forceinline__ unsigned xb_ld(unsigned* p)              { return __hip_atomic_load(p, __ATOMIC_RELAXED, __HIP_MEMORY_SCOPE_AGENT); }
__device__ __forceinline__ unsigned xb_add(unsigned* p, unsigned v) { return __hip_atomic_fetch_add(p, v, __ATOMIC_RELAXED, __HIP_MEMORY_SCOPE_AGENT); }
__device__ __forceinline__ unsigned xb_xcc_id() { return (unsigned)__builtin_amdgcn_s_getreg((3 << 11) | 20) & 0xFu; }
#define XB_SPIN(cond, bar) do { unsigned _sp = 0; while (cond) { __builtin_amdgcn_s_sleep(1); \
    if ((++_sp & 255u) == 0u) { if (xb_ld(&(bar)[XB_TMO])) break; if (_sp > XB_SPIN_CAP) { atomicAdd(&(bar)[XB_TMO], 1u); break; } } } } while (0)

struct XcdBarrier {
    unsigned* bar; unsigned x; unsigned w;
    volatile LAS unsigned* st;
};

__device__ __forceinline__ XcdBarrier xcd_barrier_post(unsigned* bar, volatile LAS unsigned* st, unsigned w) {
    XcdBarrier b; b.bar = bar; b.x = xb_xcc_id(); b.st = st; b.w = w;
    if (b.w == 0u && pg8::lane_now() == 0) (void)xb_add(&bar[XB_XCNT(b.x)], 1u);
    return b;
}
__device__ __forceinline__ void xcd_barrier_complete(unsigned* bar, unsigned x, unsigned& nloc, unsigned& nx) {
    const unsigned G = gridDim.x * gridDim.y * gridDim.z;
    unsigned sum, cnt, mine, sp = 0u;
    for (;;) {
        sum = 0u; cnt = 0u; mine = 0u;
#pragma unroll
        for (unsigned j = 0; j < 16; ++j) { const unsigned c = xb_ld(&bar[XB_XCNT(j)]); sum += c; cnt += (c > 0u) ? 1u : 0u; mine = (j == x) ? c : mine; }
        if (sum == G) break;
        __builtin_amdgcn_s_sleep(1);
        if ((++sp & 255u) == 0u) { if (xb_ld(&bar[XB_TMO])) break; if (sp > XB_SPIN_CAP) { atomicAdd(&bar[XB_TMO], 1u); break; } }
    }
    nloc = mine > 0u ? mine : 1u; nx = cnt > 0u ? cnt : 1u;
}

__device__ __forceinline__ void xcd_barrier(const XcdBarrier& b) {
    asm volatile("s_waitcnt vmcnt(0)" ::: "memory");
    __syncthreads();
    if (b.w == 0u && pg8::lane_now() == 0) {
        unsigned* bar = b.bar;
        __builtin_amdgcn_s_waitcnt(0);
        unsigned nloc = b.st[0], nx = b.st[1];
        if (nloc == 0u) { xcd_barrier_complete(bar, b.x, nloc, nx); b.st[0] = nloc; b.st[1] = nx; }
        const unsigned old = xb_add(&bar[XB_XSUB(b.x)], 1u);
        const unsigned gen = old / nloc;
        if (old + 1u == (gen + 1u) * nloc) {
            __builtin_amdgcn_fence(__ATOMIC_RELEASE, "agent");
            asm volatile("s_waitcnt vmcnt(0)" ::: "memory");
            const unsigned og = xb_add(&bar[XB_TOP], 1u);
            const unsigned tg = og / nx;
            if (og + 1u == (tg + 1u) * nx) xb_add(&bar[XB_TOPGEN], 1u);
            else XB_SPIN(xb_ld(&bar[XB_TOPGEN]) == tg, bar);
            __builtin_amdgcn_fence(__ATOMIC_ACQUIRE, "agent");
            xb_add(&bar[XB_XGEN(b.x)], 1u);
            asm volatile("s_waitcnt vmcnt(0)" ::: "memory");
        } else {
            XB_SPIN(xb_ld(&bar[XB_XGEN(b.x)]) == gen, bar);
            __builtin_amdgcn_fence(__ATOMIC_ACQUIRE, "agent");
            asm volatile("s_waitcnt vmcnt(0)" ::: "memory");
        }
    }
    __syncthreads();
}
struct Frame {
    LAS unsigned char* lds;
    volatile LAS unsigned* MISC;
    gu32* ctl;
    int tid, lane, wave;
    int vcu, G;
};
__device__ __forceinline__ float wave_sum(float v) {
#pragma unroll
    for (int o = 1; o < 64; o <<= 1) v += __shfl_xor(v, o);
    return v;
}
__device__ __forceinline__ size_t wlin_off(int n, int kbyte, int KB) {
    const int nl = n & 255, n7 = nl & 127, c32 = n7 & 31;
    const int rho = (n7 & ~31) + ((c32 >> 2) & 1) * 16 + ((c32 >> 3) << 2) + (c32 & 3);
    return (size_t)(n >> 8) * 256 * KB + (size_t)(kbyte >> 7) * 32768 + (nl >> 7) * 16384 + pg8::lds_byte(rho, (kbyte & 127) >> 1) + (kbyte & 1);
}
struct CvItem { const float* W; const float* g; bf16* WT; int K, N, row_off, r; float f8; unsigned* cmax; int q8;         };
__device__ __forceinline__ void cv_load(const CvItem& c, f32x4 (&v)[8], int lane) {
    const int nblk = c.N / 32, kb = c.r / nblk, nb = c.r % nblk, k0 = 64 * kb, n0 = 32 * nb; const int kq = lane >> 3, n4 = (lane & 7) * 4;
#pragma unroll
    for (int i = 0; i < 8; ++i) v[i] = *(const GAS f32x4*)(c.W + (size_t)(k0 + 8 * i + kq) * c.N + n0 + n4);
}
__device__ __forceinline__ void cv_finish(const CvItem& c, const f32x4 (&v)[8], LAS float* scr, int lane) {
    const int nblk = c.N / 32, kb = c.r / nblk, nb = c.r % nblk, k0 = 64 * kb, n0 = 32 * nb; const int kq = lane >> 3, n4 = (lane & 7) * 4;
#pragma unroll
    for (int i = 0; i < 8; ++i) { LAS float* d = scr + (8 * i + kq) * 33 + n4; d[0] = v[i].x; d[1] = v[i].y; d[2] = v[i].z; d[3] = v[i].w; }
    const int cc = lane & 7;
    f32x4 g0 = (f32x4){1.f, 1.f, 1.f, 1.f}, g1 = g0;
    if (c.g) { g0 = *(const f32x4*)(c.g + k0 + 8 * cc); g1 = *(const f32x4*)(c.g + k0 + 8 * cc + 4); }
    LDS_WAIT(); asm volatile("" ::: "memory");
#pragma unroll
    for (int j = 0; j < 4; ++j) { const int n = (lane >> 3) + 8 * j; const LAS float* s = scr + (8 * cc) * 33 + n;
        float gg[8]; gg[0] = g0[0]; gg[1] = g0[1]; gg[2] = g0[2]; gg[3] = g0[3]; gg[4] = g1[0]; gg[5] = g1[1]; gg[6] = g1[2]; gg[7] = g1[3];
        if (c.cmax && !c.q8) { float mx = 0.f;
#pragma unroll
            for (int e = 0; e < 8; ++e) mx = fmaxf(mx, fabsf(s[e * 33] * gg[e]));
            mx = fmaxf(mx, __shfl_xor(mx, 1)); mx = fmaxf(mx, __shfl_xor(mx, 2)); mx = fmaxf(mx, __shfl_xor(mx, 4));
            if (cc == 0) __hip_atomic_fetch_max(c.cmax + n0 + n, __builtin_bit_cast(unsigned, mx), __ATOMIC_RELAXED, __HIP_MEMORY_SCOPE_AGENT);
            continue; }
        if (c.cmax && c.q8) { const float qs = 127.0f / fmaxf(__builtin_bit_cast(float, c.cmax[n0 + n]), 1e-30f); int q[8];
#pragma unroll
            for (int e = 0; e < 8; ++e) q[e] = (int)rintf(s[e * 33] * gg[e] * qs);
            if (I8_TEST == 1 || I8_TEST == 3) { const float dq = 1.0f / qs; v4u o; o.x = pk2(q[0] * dq, q[1] * dq); o.y = pk2(q[2] * dq, q[3] * dq); o.z = pk2(q[4] * dq, q[5] * dq); o.w = pk2(q[6] * dq, q[7] * dq);
                *(GAS v4u*)((unsigned char*)c.WT + wlin_off(c.row_off + n0 + n, (k0 + 8 * cc) * 2, c.K * 2)) = o; continue; }
            v2u o8; o8.x = (unsigned)(q[0] & 255) | ((unsigned)(q[1] & 255) << 8) | ((unsigned)(q[2] & 255) << 16) | ((unsigned)(q[3] & 255) << 24);
            o8.y = (unsigned)(q[4] & 255) | ((unsigned)(q[5] & 255) << 8) | ((unsigned)(q[6] & 255) << 16) | ((unsigned)(q[7] & 255) << 24);
            *(GAS v2u*)((unsigned char*)c.WT + wlin_off(c.row_off + n0 + n, k0 + 8 * cc, c.K)) = o8; continue; }
        if (c.f8 != 0.f) { const float f = c.f8; v2u o8; o8.x = pg8::pk_fp8x4(s[0 * 33] * f, s[1 * 33] * f, s[2 * 33] * f, s[3 * 33] * f); o8.y = pg8::pk_fp8x4(s[4 * 33] * f, s[5 * 33] * f, s[6 * 33] * f, s[7 * 33] * f);
            *(GAS v2u*)((unsigned char*)c.WT + wlin_off(c.row_off + n0 + n, k0 + 8 * cc, c.K)) = o8; continue; }
        v4u o; o.x = pk2(s[0 * 33] * g0[0], s[1 * 33] * g0[1]); o.y = pk2(s[2 * 33] * g0[2], s[3 * 33] * g0[3]); o.z = pk2(s[4 * 33] * g1[0], s[5 * 33] * g1[1]); o.w = pk2(s[6 * 33] * g1[2], s[7 * 33] * g1[3]);
        *(GAS v4u*)((unsigned char*)c.WT + wlin_off(c.row_off + n0 + n, (k0 + 8 * cc) * 2, c.K * 2)) = o; }
    LDS_WAIT(); asm volatile("" ::: "memory");
}
__device__ __forceinline__ void rms_row_to_bf16(const float* xrow, bf16* orow, float* rsp, int lane) {
    f32x4 v[4][2]; float s = 0.f;
#pragma unroll
    for (int j = 0; j < 4; ++j)
#pragma unroll
        for (int e = 0; e < 2; ++e) { v[j][e] = *(const GAS f32x4*)(xrow + j * 512 + 8 * lane + 4 * e); s += (v[j][e].x * v[j][e].x + v[j][e].y * v[j][e].y) + (v[j][e].z * v[j][e].z + v[j][e].w * v[j][e].w); }
    const float rs = 1.0f / sqrtf(wave_sum(s) * (1.f / D) + RMS_EPS);
    if (lane == 0) *rsp = rs;
#pragma unroll
    for (int j = 0; j < 4; ++j) { v4u o; o.x = pk2(v[j][0].x, v[j][0].y); o.y = pk2(v[j][0].z, v[j][0].w); o.z = pk2(v[j][1].x, v[j][1].y); o.w = pk2(v[j][1].z, v[j][1].w);
        *(GAS v4u*)(orow + j * 512 + 8 * lane) = o; }
}
template <bool LAST>
__device__ __forceinline__ void thin_phase(Frame& F, const bf16* Y, const float* XF, bf16* XR, float* RS, float* OUT, const float* gpost, signed char* XQ = nullptr) {
    const int gw = F.vcu * NWAVES + F.wave, NGW = F.G * NWAVES, lane = pg8::lane_now();
    f32x4 g[4][2];
#pragma unroll
    for (int j = 0; j < 4; ++j)
#pragma unroll
        for (int e = 0; e < 2; ++e) g[j][e] = *(const GAS f32x4*)(gpost + j * 512 + 8 * lane + 4 * e);
    for (int m = gw; m < M; m += NGW) {
        const bf16* yr = Y + (size_t)m * D; bf16* xrr = XR + (size_t)m * D;
        v4u yv[4]; f32x4 xv[4][2];
#pragma unroll
        for (int j = 0; j < 4; ++j) yv[j] = Y_BLK ? *(const GAS v4u*)(Y + ((size_t)((m >> 8) * 8 + 2 * j + (lane >> 5)) * 256 + (m & 255)) * 256 + 8 * (lane & 31))
                                             : *(const GAS v4u*)(yr + j * 512 + 8 * lane);
        if (XF) {
            const float* xr = XF + (size_t)m * D;
#pragma unroll
            for (int j = 0; j < 4; ++j) { xv[j][0] = *(const GAS f32x4*)(xr + j * 512 + 8 * lane); xv[j][1] = *(const GAS f32x4*)(xr + j * 512 + 8 * lane + 4); }
        } else {
#pragma unroll
            for (int j = 0; j < 4; ++j) { const v4u w = *(const GAS v4u*)(xrr + j * 512 + 8 * lane);
                xv[j][0] = (f32x4){bflo(w.x), bfhi(w.x), bflo(w.y), bfhi(w.y)}; xv[j][1] = (f32x4){bflo(w.z), bfhi(w.z), bflo(w.w), bfhi(w.w)}; }
        }
        f32x4 yf[4][2]; float s = 0.f;
#pragma unroll
        for (int j = 0; j < 4; ++j) { yf[j][0] = (f32x4){bflo(yv[j].x), bfhi(yv[j].x), bflo(yv[j].y), bfhi(yv[j].y)}; yf[j][1] = (f32x4){bflo(yv[j].z), bfhi(yv[j].z), bflo(yv[j].w), bfhi(yv[j].w)};
#pragma unroll
            for (int e = 0; e < 2; ++e) s += (yf[j][e].x * yf[j][e].x + yf[j][e].y * yf[j][e].y) + (yf[j][e].z * yf[j][e].z + yf[j][e].w * yf[j][e].w); }
        const float rs = 1.0f / sqrtf(wave_sum(s) * (1.f / D) + RMS_EPS);
        float s2 = 0.f;
#pragma unroll
        for (int j = 0; j < 4; ++j)
#pragma unroll
            for (int e = 0; e < 2; ++e) { xv[j][e] = xv[j][e] + (yf[j][e] * rs) * g[j][e]; s2 += (xv[j][e].x * xv[j][e].x + xv[j][e].y * xv[j][e].y) + (xv[j][e].z * xv[j][e].z + xv[j][e].w * xv[j][e].w); }
        if (LAST) {
            float* xo = OUT + (size_t)m * D;
#pragma unroll
            for (int j = 0; j < 4; ++j) { *(GAS f32x4*)(xo + j * 512 + 8 * lane) = xv[j][0]; *(GAS f32x4*)(xo + j * 512 + 8 * lane + 4) = xv[j][1]; }
        } else {
            const float rs2 = 1.0f / sqrtf(wave_sum(s2) * (1.f / D) + RMS_EPS);
            if (XQ) {
                float am = 0.f;
#pragma unroll
                for (int j = 0; j < 4; ++j)
#pragma unroll
                    for (int e = 0; e < 2; ++e) am = fmaxf(fmaxf(am, fmaxf(fabsf(xv[j][e].x), fabsf(xv[j][e].y))), fmaxf(fabsf(xv[j][e].z), fabsf(xv[j][e].w)));
#pragma unroll
                for (int o = 1; o < 64; o <<= 1) am = fmaxf(am, __shfl_xor(am, o));
                am = fmaxf(am, 1e-30f);
                const float qs = 127.0f / am;
                if (I8_TEST == 2 || I8_TEST == 3) {
                    if (lane == 0) RS[m] = rs2;
#pragma unroll
                    for (int j = 0; j < 4; ++j)
#pragma unroll
                        for (int e = 0; e < 2; ++e) { xv[j][e].x = rintf(xv[j][e].x * qs) / qs; xv[j][e].y = rintf(xv[j][e].y * qs) / qs; xv[j][e].z = rintf(xv[j][e].z * qs) / qs; xv[j][e].w = rintf(xv[j][e].w * qs) / qs; }
                } else {
                if (lane == 0) RS[m] = rs2 * am * (1.0f / 127.0f);
                signed char* xq = XQ + (size_t)m * D;
#pragma unroll
                for (int j = 0; j < 4; ++j) { int q[8];
#pragma unroll
                    for (int e = 0; e < 2; ++e) { q[4 * e + 0] = (int)rintf(xv[j][e].x * qs); q[4 * e + 1] = (int)rintf(xv[j][e].y * qs); q[4 * e + 2] = (int)rintf(xv[j][e].z * qs); q[4 * e + 3] = (int)rintf(xv[j][e].w * qs); }
                    v2u w; w.x = (unsigned)(q[0] & 255) | ((unsigned)(q[1] & 255) << 8) | ((unsigned)(q[2] & 255) << 16) | ((unsigned)(q[3] & 255) << 24);
                    w.y = (unsigned)(q[4] & 255) | ((unsigned)(q[5] & 255) << 8) | ((unsigned)(q[6] & 255) << 16) | ((unsigned)(q[7] & 255) << 24);
                    *(GAS v2u*)(xq + j * 512 + 8 * lane) = w; }
                }
            } else
            if (lane == 0) RS[m] = rs2;
#pragma unroll
            for (int j = 0; j < 4; ++j) { v4u o; o.x = pk2(xv[j][0].x, xv[j][0].y); o.y = pk2(xv[j][0].z, xv[j][0].w); o.z = pk2(xv[j][1].x, xv[j][1].y); o.w = pk2(xv[j][1].z, xv[j][1].w);
                *(GAS v4u*)(xrr + j * 512 + 8 * lane) = o; }
        }
    }
}
#ifndef ATTN_STEADY
#define ATTN_STEADY 1
#endif
#ifndef AT_VTR
#define AT_VTR 1
#endif
#ifndef AT_PRIO
#define AT_PRIO 0
#endif
#ifndef AT_MSUM
#define AT_MSUM 0
#endif
#ifndef AT_EARLY_PREFETCH
#define AT_EARLY_PREFETCH 1
#endif
constexpr int AT_SKEW = 4;
constexpr int AT_ROWB = 144;
constexpr int AT_VROWB = AT_VTR ? 192 : AT_ROWB;
constexpr int AT_TILEB = 64 * AT_ROWB, AT_VTILEB = 64 * AT_VROWB, AT_BUFB = AT_TILEB + AT_VTILEB, AT_STAGEB = 2 * AT_BUFB;
typedef short at_s16x4 __attribute__((ext_vector_type(4)));
__device__ __forceinline__ bf16x8 at_vtr(const LAS unsigned char* p) {
    const at_s16x4 a = __builtin_amdgcn_ds_read_tr16_b64_v4i16((LAS at_s16x4*)(p)), b = __builtin_amdgcn_ds_read_tr16_b64_v4i16((LAS at_s16x4*)(p + 4 * AT_VROWB));
    return (bf16x8){a[0], a[1], a[2], a[3], b[0], b[1], b[2], b[3]}; }
constexpr int AT_KM_OFF = 2 * AT_STAGEB + 256, AT_KM_ROWB = 272;
typedef float at_v2f __attribute__((ext_vector_type(2)));
#define ST_SB() __builtin_amdgcn_sched_barrier(0)
#define ST_MF(A_, B_, C_) ((EXPT == 3) ? (C_) : __builtin_amdgcn_mfma_f32_32x32x16_bf16(A_, B_, C_, 0, 0, 0))
#define ST_EX(X_) ((EXPT == 4) ? (X_) : __builtin_amdgcn_exp2f(X_))
#define ST_PIN(X) asm volatile("" : "+v"(X))
#define ST_KRD(BUF, HF, K0, K1, K2, K3) do { const LAS unsigned char* kb_ = (BUF) + kfo + (HF) * 32 * AT_ROWB; \
    K0 = *(const LAS bf16x8*)(kb_); K1 = *(const LAS bf16x8*)(kb_ + 32); K2 = *(const LAS bf16x8*)(kb_ + 64); K3 = *(const LAS bf16x8*)(kb_ + 96); } while (0)
#define ST_CINIT(A, T0G, JT, HF, P) do { const int s0_ = (JT) * 64 + 32 * (HF); const int j_ = (JT) >> 2; const bool sel_ = (MODE == 0) || (j_ == qb) || ((A.sel >> j_) & 1u); \
    const float base_ = sel_ ? slope2 * (float)(s0_ + 8 * hi - (T0G) - r32) - A.mref : -INFINITY; \
    _Pragma("unroll") for (int r = 0; r < 16; ++r) { const float c = (float)(16 * (r >> 3) + (r & 7)); P[r] = __builtin_fmaf(slope2, c, base_); } } while (0)
#define ST_EXP4(P, J) do { P[4 * (J)] = ST_EX(P[4 * (J)]); P[4 * (J) + 1] = ST_EX(P[4 * (J) + 1]); P[4 * (J) + 2] = ST_EX(P[4 * (J) + 2]); P[4 * (J) + 3] = ST_EX(P[4 * (J) + 3]); } while (0)
#define ST_MAXA(P, MA) do { MA = __builtin_fmaxf(__builtin_fmaxf(P[0], P[1]), P[2]); MA = __builtin_fmaxf(__builtin_fmaxf(MA, P[3]), P[4]); MA = __builtin_fmaxf(__builtin_fmaxf(MA, P[5]), P[6]); MA = __builtin_fmaxf(MA, P[7]); } while (0)
#define ST_MAXB(P, MA, MT) do { float mb_ = __builtin_fmaxf(__builtin_fmaxf(P[8], P[9]), P[10]); mb_ = __builtin_fmaxf(__builtin_fmaxf(mb_, P[11]), P[12]); mb_ = __builtin_fmaxf(__builtin_fmaxf(mb_, P[13]), P[14]); MT = __builtin_fmaxf(__builtin_fmaxf(mb_, P[15]), MA); } while (0)
#define ST_SUMCVT(A, P, PW0, PW1) do { if (!AT_MSUM) { float ls_ = ((P[0] + P[1]) + (P[2] + P[3])) + ((P[4] + P[5]) + (P[6] + P[7])); ls_ += ((P[8] + P[9]) + (P[10] + P[11])) + ((P[12] + P[13]) + (P[14] + P[15])); A.lrow += ls_; } \
    PW0.x = cvtpk(P[0], P[1]); PW0.y = cvtpk(P[2], P[3]); PW0.z = cvtpk(P[4], P[5]); PW0.w = cvtpk(P[6], P[7]); PW1.x = cvtpk(P[8], P[9]); PW1.y = cvtpk(P[10], P[11]); PW1.z = cvtpk(P[12], P[13]); PW1.w = cvtpk(P[14], P[15]); } while (0)
#define ST_VRD(BUF, HF, VA0, VB0, VA1, VB1) do { VA0 = ST_V(BUF, HF, 0, 0); VB0 = ST_V(BUF, HF, 0, 1); VA1 = ST_V(BUF, HF, 1, 0); VB1 = ST_V(BUF, HF, 1, 1); } while (0)
#define ST_CHK(A, P, MT) do { if (EXPT != 5 && __any(MT > 8.0f)) { const float m2 = __builtin_fmaxf(MT, __shfl_xor(MT, 32)); const float dl = (m2 > 8.0f) ? m2 : 0.f; A.mref += dl; const float alpha = __builtin_amdgcn_exp2f(-dl); A.lrow *= alpha; \
    if (AT_MSUM) { if (A.gi == 0) osum[0] *= alpha; else osum[8] *= alpha; } _Pragma("unroll") for (int r = 0; r < 16; ++r) { A.o0[r] *= alpha; A.o1[r] *= alpha; P[r] -= dl; } } } while (0)
#define ST_HEAD(An, T0n, JTn, HFn, BUFn, Pn, MTn) do { bf16x8 k0_, k1_, k2_, k3_; ST_KRD(BUFn, HFn, k0_, k1_, k2_, k3_); ST_CINIT(An, T0n, JTn, HFn, Pn); \
    Pn = __builtin_amdgcn_mfma_f32_32x32x16_bf16(k0_, An.qr[0], Pn, 0, 0, 0); Pn = __builtin_amdgcn_mfma_f32_32x32x16_bf16(k1_, An.qr[1], Pn, 0, 0, 0); \
    Pn = __builtin_amdgcn_mfma_f32_32x32x16_bf16(k2_, An.qr[2], Pn, 0, 0, 0); Pn = __builtin_amdgcn_mfma_f32_32x32x16_bf16(k3_, An.qr[3], Pn, 0, 0, 0); \
    if (need_chk) { float ma_; ST_MAXA(Pn, ma_); ST_MAXB(Pn, ma_, MTn); ST_CHK(An, Pn, MTn); } } while (0)
#define ST_K(BUF, HF, D0) (*(const LAS bf16x8*)((BUF) + kfo + (HF) * 32 * AT_ROWB + 32 * (D0)))
#define ST_V(BUF, HF, SP, DB) (AT_VTR ? at_vtr((BUF) + vfo + (32 * (HF) + 16 * (SP)) * AT_VROWB + (DB) * 64) : *(const LAS bf16x8*)((BUF) + vfo + (HF) * 64 + 32 * (SP) + (DB) * 32 * AT_ROWB))
#define ST_JOIN(An, T0n, JTn, HFn, BUFn, Pn, MTn, Ac, HFc, BUFc, Pc) do { \
    const bf16x8 k0_ = ST_K(BUFn, HFn, 0), k1_ = ST_K(BUFn, HFn, 1), k2_ = ST_K(BUFn, HFn, 2), k3_ = ST_K(BUFn, HFn, 3); ST_CINIT(An, T0n, JTn, HFn, Pn); ST_EXP4(Pc, 0); ST_EXP4(Pc, 1); ST_PIN(Pc); ST_SB(); \
    Pn = ST_MF(k0_, An.qr[0], Pn); bf16x8 va_ = ST_V(BUFc, HFc, 0, 0), vb_ = ST_V(BUFc, HFc, 0, 1); ST_EXP4(Pc, 2); ST_PIN(Pc); ST_SB(); \
    Pn = ST_MF(k1_, An.qr[1], Pn); ST_EXP4(Pc, 3); ST_PIN(Pc); ST_SB(); \
    v4u pw0_, pw1_; \
    Pn = ST_MF(k2_, An.qr[2], Pn); ST_SUMCVT(Ac, Pc, pw0_, pw1_); ST_SB(); \
    Pn = ST_MF(k3_, An.qr[3], Pn); ST_SB(); \
    float ma_; \
    Ac.o0 = ST_MF(va_, __builtin_bit_cast(bf16x8, pw0_), Ac.o0); Ac.o1 = ST_MF(vb_, __builtin_bit_cast(bf16x8, pw0_), Ac.o1); \
    va_ = ST_V(BUFc, HFc, 1, 0); vb_ = ST_V(BUFc, HFc, 1, 1); ST_SB(); \
    Ac.o0 = ST_MF(va_, __builtin_bit_cast(bf16x8, pw1_), Ac.o0); Ac.o1 = ST_MF(vb_, __builtin_bit_cast(bf16x8, pw1_), Ac.o1); \
    if (AT_MSUM) { osum = ST_MF(Ac.of, __builtin_bit_cast(bf16x8, pw0_), osum); osum = ST_MF(Ac.of, __builtin_bit_cast(bf16x8, pw1_), osum); } ST_SB(); \
    if (need_chk) { ST_MAXA(Pn, ma_); ST_MAXB(Pn, ma_, MTn); ST_CHK(An, Pn, MTn); } } while (0)
#define ST_TAIL(Ac, HFc, BUFc, Pc) do { ST_EXP4(Pc, 0); ST_EXP4(Pc, 1); ST_EXP4(Pc, 2); ST_EXP4(Pc, 3); bf16x8 va0_, vb0_, va1_, vb1_; ST_VRD(BUFc, HFc, va0_, vb0_, va1_, vb1_); v4u pw0_, pw1_; ST_SUMCVT(Ac, Pc, pw0_, pw1_); \
    Ac.o0 = __builtin_amdgcn_mfma_f32_32x32x16_bf16(va0_, __builtin_bit_cast(bf16x8, pw0_), Ac.o0, 0, 0, 0); Ac.o1 = __builtin_amdgcn_mfma_f32_32x32x16_bf16(vb0_, __builtin_bit_cast(bf16x8, pw0_), Ac.o1, 0, 0, 0); \
    Ac.o0 = __builtin_amdgcn_mfma_f32_32x32x16_bf16(va1_, __builtin_bit_cast(bf16x8, pw1_), Ac.o0, 0, 0, 0); Ac.o1 = __builtin_amdgcn_mfma_f32_32x32x16_bf16(vb1_, __builtin_bit_cast(bf16x8, pw1_), Ac.o1, 0, 0, 0); \
    if (AT_MSUM) { osum = __builtin_amdgcn_mfma_f32_32x32x16_bf16(Ac.of, __builtin_bit_cast(bf16x8, pw0_), osum, 0, 0, 0); osum = __builtin_amdgcn_mfma_f32_32x32x16_bf16(Ac.of, __builtin_bit_cast(bf16x8, pw1_), osum, 0, 0, 0); } } while (0)
struct AttnGrp { bf16x8 qr[4]; f32x16 o0, o1; bf16x8 of; float mref, lrow, cs; unsigned sel; int gi; };
#define AT_UNIT_DESC(U, B_, KVH_, TG_) const int B_ = vcu >> 6, KVH_ = (U); const int TG_ = ((U) & 1) ? 63 - (vcu & 63) : (vcu & 63);
template <int MODE, int EXPT = 0>
__device__ __forceinline__ void attn_units(int wave, int vcu, const bf16* QO, bf16* OB, const bf16* Kb, const bf16* Vt, const float* kmean, const float* kmaxp, const float* sinks, LAS unsigned char* lds) {
    int tid_ = pg8::wave_tid(wave); asm volatile("" : "+v"(tid_));
    const int wid = wave;
    const int sdst = (tid_ >> 3) * AT_ROWB + (tid_ & 7) * 16;
    const int r32o = tid_ & 31, hio = (tid_ >> 5) & 1;
    const int i16 = r32o & 15, krow = (r32o & 16) + ((i16 & 3) | (((i16 >> 3) & 1) << 2) | (((i16 >> 2) & 1) << 3));
    const int kfo = krow * AT_ROWB + hio * 16;
    const int vfo = AT_VTR ? AT_TILEB + (8 * hio + ((r32o & 15) >> 2)) * AT_VROWB + 32 * ((r32o >> 4) & 1) + 8 * (r32o & 3)
                           : AT_TILEB + r32o * AT_ROWB + hio * 16;
    const int sdstv = AT_VTR ? (tid_ >> 3) * AT_VROWB + (tid_ & 7) * 16 : sdst;
    AttnGrp G[2];
    f32x16 osum;
    v4u kst0, vst0, kst1, vst1; at_v2f kmst = {0.f, 0.f};
    bf16x8 qn[2][4];
#define AT_UNIT_LOADS(B_, KVH_, TG_) do { \
        int r32_ = r32, srow_ = srow; asm volatile("" : "+v"(r32_), "+v"(srow_));     \
        const int h_ = (KVH_) * 8 + wid, t0_ = (TG_) * 64; const size_t rb_ = (size_t)(B_) * SEQ; \
        _Pragma("unroll") for (int g = 0; g < 2; ++g) { const size_t qrow_ = rb_ + t0_ + 32 * g + r32_; \
            const bf16* Qw = QO_BLK ? QO + ((size_t)((qrow_ >> 8) * 8 + (h_ >> 2)) * 256 + (qrow_ & 255)) * 256 + (h_ & 3) * 64 + hi * 8 : QO + qrow_ * D + h_ * HD + hi * 8;     \
            _Pragma("unroll") for (int d0 = 0; d0 < 4; ++d0) qn[g][d0] = *(const GAS bf16x8*)(Qw + d0 * 16); } \
        const int jl_ = (MODE == 0) ? ((t0_ >= 128 ? t0_ - 127 : 0) >> 6) : 0, jh_ = (TG_); \
        const bf16* kg_ = Kb + (rb_ + srow_) * 256 + (KVH_) * 64 + sch * 8; const bf16* vg_ = AT_VTR ? Vt + (rb_ + srow_) * 256 + (KVH_) * 64 + sch * 8 : Vt + ((size_t)(((B_) * 4 + (KVH_)) * 64 + srow_)) * SEQ + sch * 8; \
        kst0 = *(const GAS v4u*)(kg_ + (size_t)(jh_ * 64) * 256); vst0 = *(const GAS v4u*)(vg_ + (size_t)(jh_ * 64) * (AT_VTR ? 256 : 1)); \
        if (jh_ > jl_) { kst1 = *(const GAS v4u*)(kg_ + (size_t)((jh_ - 1) * 64) * 256); vst1 = *(const GAS v4u*)(vg_ + (size_t)((jh_ - 1) * 64) * (AT_VTR ? 256 : 1)); } \
        if (MODE == 1) kmst = *(const GAS at_v2f*)(kmean + ((size_t)((B_) * 16 + (srow_ >> 2))) * 256 + (KVH_) * 64 + ((((srow_ & 3) << 3) + sch) << 1)); } while (0)
    { const int r32 = tid_ & 31, hi = (tid_ >> 5) & 1, srow = tid_ >> 3, sch = tid_ & 7; AT_UNIT_DESC(0, b0_, k0_, g0_) AT_UNIT_LOADS(b0_, k0_, g0_); }
    float kbd0, kbd1, kbd2, kbd3;
    { const float* kp = kmaxp + (vcu >> 6) * 8; kbd0 = sqrtf(kp[0] + kp[1]) * 1.02f; kbd1 = sqrtf(kp[2] + kp[3]) * 1.02f; kbd2 = sqrtf(kp[4] + kp[5]) * 1.02f; kbd3 = sqrtf(kp[6] + kp[7]) * 1.02f;
      kbd0 = __builtin_bit_cast(float, __builtin_amdgcn_readfirstlane(__builtin_bit_cast(int, kbd0))); kbd1 = __builtin_bit_cast(float, __builtin_amdgcn_readfirstlane(__builtin_bit_cast(int, kbd1)));
      kbd2 = __builtin_bit_cast(float, __builtin_amdgcn_readfirstlane(__builtin_bit_cast(int, kbd2))); kbd3 = __builtin_bit_cast(float, __builtin_amdgcn_readfirstlane(__builtin_bit_cast(int, kbd3))); }
    for (int un = 0; un < 4; ++un) {
    int tidl_ = tid_; asm volatile("" : "+v"(tidl_));
    const int tid = tidl_, lane = tid & 63, r32 = lane & 31, hi = lane >> 5, srow = tid >> 3, sch = tid & 7;
    AT_UNIT_DESC(un, b, kvh, tg)
    const int h = kvh * 8 + wid, t0 = tg * 64; const size_t rowbase = (size_t)b * SEQ;
    const float slope2 = __builtin_amdgcn_exp2f(-0.25f * (float)(h + 1)) * LOG2E;
#pragma unroll
    for (int g = 0; g < 2; ++g)
#pragma unroll
      for (int d0 = 0; d0 < 4; ++d0) G[g].qr[d0] = qn[g][d0];
    G[0].gi = 0; G[1].gi = 1;
    if (MODE == 1 && AT_MSUM) { const unsigned o0_ = (r32 < 16) ? 0x3f803f80u : 0u, o1_ = (r32 < 16) ? 0u : 0x3f803f80u;
        G[0].of = __builtin_bit_cast(bf16x8, (v4u){o0_, o0_, o0_, o0_}); G[1].of = __builtin_bit_cast(bf16x8, (v4u){o1_, o1_, o1_, o1_}); }
    int jt_lo = (MODE == 0) ? ((t0 >= 128 ? t0 - 127 : 0) >> 6) : 0; const int jt_hi = tg;
    const bf16* kg = Kb + (rowbase + srow) * 256 + kvh * 64 + sch * 8;
    const bf16* vg = AT_VTR ? Vt + (rowbase + srow) * 256 + kvh * 64 + sch * 8 : Vt + ((size_t)((b * 4 + kvh) * 64 + srow)) * SEQ + sch * 8;
    const int qb = t0 >> 8;
    const float kbound = (kvh == 0) ? kbd0 : (kvh == 1) ? kbd1 : (kvh == 2) ? kbd2 : kbd3;
#pragma unroll
    for (int g = 0; g < 2; ++g) {
        float q2 = 0.f;
#pragma unroll
        for (int d0 = 0; d0 < 4; ++d0)
#pragma unroll
            for (int e = 0; e < 1; ++e) { const v4u qw = __builtin_bit_cast(v4u, G[g].qr[d0]); const f32x4 ql = __builtin_bit_cast(f32x4, qw << 16), qh = __builtin_bit_cast(f32x4, qw & 0xffff0000u);
                q2 += (ql.x * ql.x + ql.y * ql.y) + (ql.z * ql.z + ql.w * ql.w) + (qh.x * qh.x + qh.y * qh.y) + (qh.z * qh.z + qh.w * qh.w); }
        q2 += __shfl_xor(q2, 32);
        G[g].cs = sqrtf(q2) * kbound;
        G[g].mref = 0.f; G[g].lrow = 0.f;
    }
    const bool need_chk = !__all(fmaxf(G[0].cs, G[1].cs) < 40.0f);
    float smin_w = -1e30f;
    *(LAS v4u*)(lds + sdst) = kst0; *(LAS v4u*)(lds + AT_TILEB + sdstv) = vst0;
    if (jt_hi > jt_lo) { *(LAS v4u*)(lds + AT_BUFB + sdst) = kst1; *(LAS v4u*)(lds + AT_BUFB + AT_TILEB + sdstv) = vst1; }
    if (MODE == 1) *(LAS at_v2f*)(lds + AT_KM_OFF + (tid >> 5) * AT_KM_ROWB + (tid & 31) * 8) = kmst;
    __syncthreads();
    G[0].sel = 0u; G[1].sel = 0u;
    if (MODE == 1 && EXPT != 9) {
        const LAS unsigned char* kml = lds + AT_KM_OFF + (r32 < 16 ? r32 : 15) * AT_KM_ROWB + hi * 32;
        f32x4 kk[4][2];
#pragma unroll
        for (int d0 = 0; d0 < 4; ++d0) { kk[d0][0] = *(const LAS f32x4*)(kml + d0 * 64); kk[d0][1] = *(const LAS f32x4*)(kml + d0 * 64 + 16); }
        const float zm = (r32 < 16) ? 1.f : 0.f;
        f32x16 gg[2];
#pragma unroll
        for (int r = 0; r < 16; ++r) { gg[0][r] = 0.f; gg[1][r] = 0.f; }
#pragma unroll
        for (int d0 = 0; d0 < 4; ++d0) { const f32x4 k0 = kk[d0][0] * zm, k1 = kk[d0][1] * zm; v4u wh, wl;
            wh.x = pk2(k0.x, k0.y); wh.y = pk2(k0.z, k0.w); wh.z = pk2(k1.x, k1.y); wh.w = pk2(k1.z, k1.w);
            wl.x = pk2(k0.x - bflo(wh.x), k0.y - bfhi(wh.x)); wl.y = pk2(k0.z - bflo(wh.y), k0.w - bfhi(wh.y)); wl.z = pk2(k1.x - bflo(wh.z), k1.y - bfhi(wh.z)); wl.w = pk2(k1.z - bflo(wh.w), k1.w - bfhi(wh.w));
#pragma unroll
            for (int g = 0; g < 2; ++g) {
                gg[g] = __builtin_amdgcn_mfma_f32_32x32x16_bf16(__builtin_bit_cast(bf16x8, wh), G[g].qr[d0], gg[g], 0, 0, 0);
                gg[g] = __builtin_amdgcn_mfma_f32_32x32x16_bf16(__builtin_bit_cast(bf16x8, wl), G[g].qr[d0], gg[g], 0, 0, 0); }
        }
#pragma unroll
        for (int g = 0; g < 2; ++g) {
            const f32x16 ga = gg[g];
            float pg[8];
#pragma unroll
            for (int r = 0; r < 8; ++r) pg[r] = __shfl_xor(ga[r], 32);
            float GV[16];
#pragma unroll
            for (int blk = 0; blk < 16; ++blk) { const int q4 = blk >> 2, reg = (blk & 3) + 4 * (q4 >> 1); GV[blk] = ((q4 & 1) == hi) ? ga[reg] : pg[reg]; }
            unsigned selmask = 0u;
#pragma unroll
            for (int it = 0; it < 3; ++it) { float best = -INFINITY; int bi = -1;
#pragma unroll
                for (int blk = 0; blk < 16; ++blk) { const bool ok = (blk < qb) && !((selmask >> blk) & 1u) && (GV[blk] > best); best = ok ? GV[blk] : best; bi = ok ? blk : bi; }
                if (bi >= 0) selmask |= 1u << bi; }
            G[g].sel = selmask;
        }
    }
#pragma unroll
    for (int g = 0; g < 2; ++g)
#pragma unroll
        for (int r = 0; r < 16; ++r) { G[g].o0[r] = 0.f; G[g].o1[r] = 0.f; if (MODE == 1 && AT_MSUM) osum[r] = 0.f; }
    int cur = 0;
#define AT_STAGE_BEGIN(JS) \
        const bool more0 = (JS) - 2 >= jt_lo, more1 = (JS) - 3 >= jt_lo; \
        if (more0) { kst0 = *(const GAS v4u*)(kg + (size_t)(((JS) - 2) * 64) * 256); vst0 = *(const GAS v4u*)(vg + (size_t)(((JS) - 2) * 64) * (AT_VTR ? 256 : 1)); } \
        if (more1) { kst1 = *(const GAS v4u*)(kg + (size_t)(((JS) - 3) * 64) * 256); vst1 = *(const GAS v4u*)(vg + (size_t)(((JS) - 3) * 64) * (AT_VTR ? 256 : 1)); } \
        if (wid >= 4) __builtin_amdgcn_s_sleep(AT_SKEW);
#define AT_STAGE_END() \
        { LAS unsigned char* nb = lds + (cur ^ 1) * AT_STAGEB; \
          if (more0) { *(LAS v4u*)(nb + sdst) = kst0; *(LAS v4u*)(nb + AT_TILEB + sdstv) = vst0; } \
          if (more1) { *(LAS v4u*)(nb + AT_BUFB + sdst) = kst1; *(LAS v4u*)(nb + AT_BUFB + AT_TILEB + sdstv) = vst1; } } \
        __syncthreads(); \
        cur ^= 1;
    {
        const int js = jt_hi;
        AT_STAGE_BEGIN(js)
#pragma unroll
        for (int u = 0; u < 2; ++u) {
            const int jt = js - u;
            if (jt < jt_lo) break;
            const int s0 = jt * 64;
            const LAS unsigned char* buf = lds + cur * AT_STAGEB + u * AT_BUFB;
            const bool first = (u == 0);
            float smg = 1e30f;
            if (u == 1 && ATTN_STEADY && (EXPT == 0 || EXPT >= 3)) {
                if (EXPT != 6 && !((float)(s0 + 63) < smin_w)) {
                    f32x16 pe, po; float me, mo;
                    ST_HEAD(G[0], t0, jt, 0, buf, pe, me);
                    ST_JOIN(G[1], t0 + 32, jt, 0, buf, po, mo, G[0], 0, buf, pe);
                    ST_JOIN(G[0], t0, jt, 1, buf, pe, me, G[1], 0, buf, po);
                    ST_JOIN(G[1], t0 + 32, jt, 1, buf, po, mo, G[0], 1, buf, pe);
                    ST_TAIL(G[1], 1, buf, po);
                }
            } else
            if (EXPT != 2 && !((float)(s0 + 63) < smin_w)) {
#pragma unroll
              for (int g = 0; g < 2; ++g) {
                AttnGrp& A = G[g];
                const int t0g = t0 + 32 * g;
                bool sel = true;
                if (MODE == 1) { const int j = jt >> 2; sel = (j == qb) || ((A.sel >> j) & 1u); }
                if (__any(sel)) {
                    const bool dead1 = first && g == 0;
                    const float base = sel ? slope2 * (float)(s0 + 8 * hi - t0g - r32) - A.mref : -INFINITY;
                    f32x16 p0, p1;
#pragma unroll
                    for (int r = 0; r < 16; ++r) { const float c = (float)(16 * (r >> 3) + (r & 7)); p0[r] = __builtin_fmaf(slope2, c, base); p1[r] = dead1 ? -INFINITY : __builtin_fmaf(slope2, c + 32.f, base); }
#pragma unroll
                    for (int d0 = 0; d0 < 4; ++d0) {
                        const bf16x8 ka = *(const LAS bf16x8*)(buf + kfo + d0 * 32);
                        p0 = __builtin_amdgcn_mfma_f32_32x32x16_bf16(ka, A.qr[d0], p0, 0, 0, 0);
                        if (!dead1) { const bf16x8 kb2 = *(const LAS bf16x8*)(buf + kfo + 32 * AT_ROWB + d0 * 32); p1 = __builtin_amdgcn_mfma_f32_32x32x16_bf16(kb2, A.qr[d0], p1, 0, 0, 0); }
                    }
                    const bool wnd = !first && (MODE == 0 && s0 < t0g - 96);
                    if (first || wnd) {
                        const int dq = t0g + r32 - s0 - 8 * hi;
#pragma unroll
                        for (int r = 0; r < 16; ++r) { const int c = 16 * (r >> 3) + (r & 7); const int e0 = dq - c, e1 = dq - c - 32;
                            const bool v0 = (e0 >= 0) && (MODE == 1 || e0 < 128), v1 = (e1 >= 0) && (MODE == 1 || e1 < 128);
                            if (wnd || g == 0) p0[r] = v0 ? p0[r] : -INFINITY;
                            if (wnd || g == 1) p1[r] = v1 ? p1[r] : -INFINITY; }
                    }
                    float mt, mu;
                    if (dead1) { mt = __builtin_fmaxf(__builtin_fmaxf(p0[0], p0[1]), p0[2]); mu = __builtin_fmaxf(__builtin_fmaxf(p0[3], p0[4]), p0[5]);
#pragma unroll
                        for (int r = 6; r < 16; r += 2) { mt = __builtin_fmaxf(mt, p0[r]); mu = __builtin_fmaxf(mu, p0[r + 1]); } }
                    else { mt = __builtin_fmaxf(__builtin_fmaxf(p0[0], p0[1]), p1[0]); mu = __builtin_fmaxf(__builtin_fmaxf(p0[2], p0[3]), p1[1]); mt = __builtin_fmaxf(__builtin_fmaxf(mt, p1[2]), p1[3]);
#pragma unroll
                        for (int r = 4; r < 16; r += 4) { mt = __builtin_fmaxf(__builtin_fmaxf(mt, p0[r]), p0[r + 1]); mu = __builtin_fmaxf(__builtin_fmaxf(mu, p0[r + 2]), p0[r + 3]); mt = __builtin_fmaxf(__builtin_fmaxf(mt, p1[r]), p1[r + 1]); mu = __builtin_fmaxf(__builtin_fmaxf(mu, p1[r + 2]), p1[r + 3]); } }
                    mt = __builtin_fmaxf(mt, mu);
                    if (first || __any(mt > 8.0f)) {
                        const float m2 = __builtin_fmaxf(mt, __shfl_xor(mt, 32));
                        const float dl = first ? m2 : ((m2 > 8.0f) ? m2 : 0.f);
                        A.mref += dl;
                        const float alpha = __builtin_amdgcn_exp2f(-dl);
                        if (!first) { A.lrow *= alpha;
#pragma unroll
                            for (int r = 0; r < 16; ++r) { A.o0[r] *= alpha; A.o1[r] *= alpha; } }
#pragma unroll
                        for (int r = 0; r < 16; ++r) { p0[r] -= dl; if (!dead1) p1[r] -= dl; }
                        mt -= dl;
                    }
                    if (first) smg = fminf(smg, (float)(t0g + r32) - (40.0f + A.cs - A.mref) / slope2);
                    if (EXPT != 1 && !__all(mt < -40.0f)) {
                        float ls = 0.f;
#pragma unroll
                        for (int r = 0; r < 16; ++r) { p0[r] = __builtin_amdgcn_exp2f(p0[r]); if (dead1) ls += p0[r]; else { p1[r] = __builtin_amdgcn_exp2f(p1[r]); ls += p0[r] + p1[r]; } }
                        A.lrow += ls;
#pragma unroll
                        for (int hf = 0; hf < (dead1 ? 1 : 2); ++hf)
#pragma unroll
                            for (int sp = 0; sp < 2; ++sp) {
                                v4u pw;
                                if (hf == 0) { pw.x = cvtpk(p0[8 * sp + 0], p0[8 * sp + 1]); pw.y = cvtpk(p0[8 * sp + 2], p0[8 * sp + 3]); pw.z = cvtpk(p0[8 * sp + 4], p0[8 * sp + 5]); pw.w = cvtpk(p0[8 * sp + 6], p0[8 * sp + 7]); }
                                else         { pw.x = cvtpk(p1[8 * sp + 0], p1[8 * sp + 1]); pw.y = cvtpk(p1[8 * sp + 2], p1[8 * sp + 3]); pw.z = cvtpk(p1[8 * sp + 4], p1[8 * sp + 5]); pw.w = cvtpk(p1[8 * sp + 6], p1[8 * sp + 7]); }
                                const bf16x8 pb = __builtin_bit_cast(bf16x8, pw);
                                const bf16x8 va = ST_V(buf, hf, sp, 0), vb = ST_V(buf, hf, sp, 1);
                                A.o0 = __builtin_amdgcn_mfma_f32_32x32x16_bf16(va, pb, A.o0, 0, 0, 0);
                                A.o1 = __builtin_amdgcn_mfma_f32_32x32x16_bf16(vb, pb, A.o1, 0, 0, 0);
                            }
                    }
                }
              }
            }
            if (first && EXPT != 2) {
                float sm = smg;
#pragma unroll
                for (int o = 1; o < 64; o <<= 1) sm = fminf(sm, __shfl_xor(sm, o));
                smin_w = sm;
                if (lane == 0) *(LAS float*)(lds + 2 * AT_STAGEB + wid * 4) = sm;
            }
        }
        AT_STAGE_END()
        if (EXPT != 2) {
            const LAS float* cw = (const LAS float*)(lds + 2 * AT_STAGEB);
            float sm = fminf(fminf(fminf(cw[0], cw[1]), fminf(cw[2], cw[3])), fminf(fminf(cw[4], cw[5]), fminf(cw[6], cw[7])));
            sm = fminf(fmaxf(sm, 0.f), 4096.f);
            const int jc = __builtin_amdgcn_readfirstlane((int)(sm * (1.0f / 64.0f)));
            jt_lo = jc > jt_lo ? jc : jt_lo;
            if (EXPT == 8 || EXPT == 9) jt_lo = jt_hi + 1;
        }
    }
    for (int js = jt_hi - 2; js >= jt_lo; js -= 2) {
        AT_STAGE_BEGIN(js)
        if (MODE == 1 && (EXPT == 0 || EXPT >= 3) && ATTN_STEADY) {
            if (EXPT != 6 && !((float)(js * 64 + 63) < smin_w)) {
                const LAS unsigned char* b0 = lds + cur * AT_STAGEB; const LAS unsigned char* b1 = b0 + AT_BUFB;
                f32x16 pe, po; float me, mo;
                ST_HEAD(G[0], t0, js, 0, b0, pe, me);
                ST_JOIN(G[1], t0 + 32, js, 0, b0, po, mo, G[0], 0, b0, pe);
                ST_JOIN(G[0], t0, js, 1, b0, pe, me, G[1], 0, b0, po);
                ST_JOIN(G[1], t0 + 32, js, 1, b0, po, mo, G[0], 1, b0, pe);
                if (js - 1 >= jt_lo) {
                    ST_JOIN(G[0], t0, js - 1, 0, b1, pe, me, G[1], 1, b0, po);
                    ST_JOIN(G[1], t0 + 32, js - 1, 0, b1, po, mo, G[0], 0, b1, pe);
                    ST_JOIN(G[0], t0, js - 1, 1, b1, pe, me, G[1], 0, b1, po);
                    ST_JOIN(G[1], t0 + 32, js - 1, 1, b1, po, mo, G[0], 1, b1, pe);
                    ST_TAIL(G[1], 1, b1, po);
                } else {
                    ST_TAIL(G[1], 1, b0, po);
                }
            }
        }
        else {
#pragma unroll
        for (int u = 0; u < 2; ++u) {
            const int jt = js - u;
            if (jt < jt_lo) break;
            const int s0 = jt * 64;
            const LAS unsigned char* buf = lds + cur * AT_STAGEB + u * AT_BUFB;
            const bool first = (jt == jt_hi);
            float smg = 1e30f;
            if (EXPT != 2 && !((float)(s0 + 63) < smin_w)) {
#pragma unroll
              for (int g = 0; g < 2; ++g) {
                AttnGrp& A = G[g];
                const int t0g = t0 + 32 * g;
                bool sel = true;
                if (MODE == 1) { const int j = jt >> 2; sel = (j == qb) || ((A.sel >> j) & 1u); }
                if (__any(sel)) {
                    const float base = sel ? slope2 * (float)(s0 + 8 * hi - t0g - r32) - A.mref : -INFINITY;
                    f32x16 p0, p1;
#pragma unroll
                    for (int r = 0; r < 16; ++r) { const float c = (float)(16 * (r >> 3) + (r & 7)); p0[r] = __builtin_fmaf(slope2, c, base); p1[r] = __builtin_fmaf(slope2, c + 32.f, base); }
#pragma unroll
                    for (int d0 = 0; d0 < 4; ++d0) {
                        const bf16x8 ka = *(const LAS bf16x8*)(buf + kfo + d0 * 32), kb2 = *(const LAS bf16x8*)(buf + kfo + 32 * AT_ROWB + d0 * 32);
                        p0 = __builtin_amdgcn_mfma_f32_32x32x16_bf16(ka, A.qr[d0], p0, 0, 0, 0);
                        p1 = __builtin_amdgcn_mfma_f32_32x32x16_bf16(kb2, A.qr[d0], p1, 0, 0, 0);
                    }
                    if (first || (MODE == 0 && s0 < t0g - 96)) {
                        const int dq = t0g + r32 - s0 - 8 * hi;
#pragma unroll
                        for (int r = 0; r < 16; ++r) { const int c = 16 * (r >> 3) + (r & 7); const int e0 = dq - c, e1 = dq - c - 32;
                            const bool v0 = (e0 >= 0) && (MODE == 1 || e0 < 128), v1 = (e1 >= 0) && (MODE == 1 || e1 < 128);
                            p0[r] = v0 ? p0[r] : -INFINITY; p1[r] = v1 ? p1[r] : -INFINITY; }
                    }
                    float mt = __builtin_fmaxf(__builtin_fmaxf(p0[0], p0[1]), p1[0]); float mu = __builtin_fmaxf(__builtin_fmaxf(p0[2], p0[3]), p1[1]); mt = __builtin_fmaxf(__builtin_fmaxf(mt, p1[2]), p1[3]);
#pragma unroll
                    for (int r = 4; r < 16; r += 4) { mt = __builtin_fmaxf(__builtin_fmaxf(mt, p0[r]), p0[r + 1]); mu = __builtin_fmaxf(__builtin_fmaxf(mu, p0[r + 2]), p0[r + 3]); mt = __builtin_fmaxf(__builtin_fmaxf(mt, p1[r]), p1[r + 1]); mu = __builtin_fmaxf(__builtin_fmaxf(mu, p1[r + 2]), p1[r + 3]); }
                    mt = __builtin_fmaxf(mt, mu);
                    if (first || __any(mt > 8.0f)) {
                        const float m2 = __builtin_fmaxf(mt, __shfl_xor(mt, 32));
                        const float dl = first ? m2 : ((m2 > 8.0f) ? m2 : 0.f);
                        A.mref += dl;
                        const float alpha = __builtin_amdgcn_exp2f(-dl);
                        A.lrow *= alpha;
#pragma unroll
                        for (int r = 0; r < 16; ++r) { A.o0[r] *= alpha; A.o1[r] *= alpha; p0[r] -= dl; p1[r] -= dl; }
                        mt -= dl;
                    }
                    if (first) smg = fminf(smg, (float)(t0g + r32) - (40.0f + A.cs - A.mref) / slope2);
                    if (EXPT != 1 && !__all(mt < -40.0f)) {
                        float ls = 0.f;
#pragma unroll
                        for (int r = 0; r < 16; ++r) { p0[r] = __builtin_amdgcn_exp2f(p0[r]); p1[r] = __builtin_amdgcn_exp2f(p1[r]); ls += p0[r] + p1[r]; }
                        A.lrow += ls;
#pragma unroll
                        for (int hf = 0; hf < 2; ++hf)
#pragma unroll
                            for (int sp = 0; sp < 2; ++sp) {
                                v4u pw;
                                if (hf == 0) { pw.x = cvtpk(p0[8 * sp + 0], p0[8 * sp + 1]); pw.y = cvtpk(p0[8 * sp + 2], p0[8 * sp + 3]); pw.z = cvtpk(p0[8 * sp + 4], p0[8 * sp + 5]); pw.w = cvtpk(p0[8 * sp + 6], p0[8 * sp + 7]); }
                                else         { pw.x = cvtpk(p1[8 * sp + 0], p1[8 * sp + 1]); pw.y = cvtpk(p1[8 * sp + 2], p1[8 * sp + 3]); pw.z = cvtpk(p1[8 * sp + 4], p1[8 * sp + 5]); pw.w = cvtpk(p1[8 * sp + 6], p1[8 * sp + 7]); }
                                const bf16x8 pb = __builtin_bit_cast(bf16x8, pw);
                                const bf16x8 va = ST_V(buf, hf, sp, 0), vb = ST_V(buf, hf, sp, 1);
                                A.o0 = __builtin_amdgcn_mfma_f32_32x32x16_bf16(va, pb, A.o0, 0, 0, 0);
                                A.o1 = __builtin_amdgcn_mfma_f32_32x32x16_bf16(vb, pb, A.o1, 0, 0, 0);
                            }
                    }
                }
              }
            }
            if (first && EXPT != 2) {
                float sm = smg;
#pragma unroll
                for (int o = 1; o < 64; o <<= 1) sm = fminf(sm, __shfl_xor(sm, o));
                smin_w = sm;
                if (lane == 0) *(LAS float*)(lds + 2 * AT_STAGEB + wid * 4) = sm;
            }
        }
        }
        AT_STAGE_END()
    }
#undef AT_STAGE_BEGIN
#undef AT_STAGE_END
    if (AT_EARLY_PREFETCH && un + 1 < 4) { AT_UNIT_DESC(un + 1, nb_, nk_, ng_) AT_UNIT_LOADS(nb_, nk_, ng_); }
#pragma unroll
    for (int g = 0; g < 2; ++g) {
        if (!AT_EARLY_PREFETCH && g == 1 && un + 1 < 4) { AT_UNIT_DESC(un + 1, nb_, nk_, ng_) AT_UNIT_LOADS(nb_, nk_, ng_); }
        float lt = G[g].lrow + __shfl_xor(G[g].lrow, 32);
        if (MODE == 1 && AT_MSUM) lt += osum[8 * g];
        if (MODE == 0) lt += __builtin_amdgcn_exp2f(sinks[h] * LOG2E - G[g].mref);
        const float inv = 1.0f / lt;
        const size_t orow = rowbase + t0 + 32 * g + r32;
        bf16* Ow = QO_BLK ? OB + ((size_t)((orow >> 8) * 8 + (h >> 2)) * 256 + (orow & 255)) * 256 + (h & 3) * 64 + 8 * hi : OB + orow * D + h * HD + 8 * hi;
#pragma unroll
        for (int i = 0; i < 2; ++i) {
#pragma unroll
            for (int hf2 = 0; hf2 < 2; ++hf2) {
                float keep[4], send[4], recv[4];
#pragma unroll
                for (int e = 0; e < 4; ++e) { const float va = (hf2 ? G[g].o1[8 * i + e] : G[g].o0[8 * i + e]) * inv, vb = (hf2 ? G[g].o1[8 * i + 4 + e] : G[g].o0[8 * i + 4 + e]) * inv;
                    keep[e] = hi ? vb : va; send[e] = hi ? va : vb; }
#pragma unroll
                for (int e = 0; e < 4; ++e) recv[e] = __shfl_xor(send[e], 32);
                v4u w;
                if (hi == 0) { w.x = cvtpk(keep[0], keep[1]); w.y = cvtpk(keep[2], keep[3]); w.z = cvtpk(recv[0], recv[1]); w.w = cvtpk(recv[2], recv[3]); }
                else         { w.x = cvtpk(recv[0], recv[1]); w.y = cvtpk(recv[2], recv[3]); w.z = cvtpk(keep[0], keep[1]); w.w = cvtpk(keep[2], keep[3]); }
                *(GAS v4u*)(Ow + 32 * hf2 + 16 * i) = w;
            }
        }
    }
    }
#undef AT_UNIT_LOADS
}
template <int MODE, int EXPT = 0>
__device__ __forceinline__ void attn_phase(Frame& F, const bf16* QO, bf16* OB, const bf16* Kb, const bf16* Vt, const float* kmean, const float* kmaxp, const float* sinks) {
    if (AT_PRIO && F.wave >= 4) __builtin_amdgcn_s_setprio(1);
    for (int v = F.vcu; v < 256; v += F.G) attn_units<MODE, EXPT>(F.wave, v, QO, OB, Kb, Vt, kmean, kmaxp, sinks, F.lds + RING_OFF);
    if (AT_PRIO) __builtin_amdgcn_s_setprio(0);
}
struct WSrc { unsigned* cmax; const float* w_qkv_a; const float* w_o_a; const float* kv_norm; const float* w_kv; const float* w_q_b; const float* w_o_b; const float* n_attn_pre; const float* n_mlp_pre; const float* w_up; const float* w_down; };
constexpr int CV_QKV = (D / 64) * (NQKV / 32), CV_O = (D / 64) * (D / 32), CV_UP = (D / 64) * (FF / 32), CV_DN = (FF / 64) * (D / 32), CV_KV = (D / 64) * (512 / 32);
constexpr int CV_L0 = CV_QKV + CV_O + CV_UP + CV_DN, CV_ALL = CV_L0 + CV_O + CV_KV + CV_O + CV_UP + CV_DN;
#ifndef SLOT_DN0
#define SLOT_DN0 1
#endif
#ifndef SLOT_MOVE
#define SLOT_MOVE 0
#endif
#ifndef SLOT_BAL
#define SLOT_BAL 1
#endif
constexpr int CV_P0 = SLOT_MOVE ? CV_QKV : CV_QKV + CV_O, CV_P1 = CV_L0 + CV_O + CV_KV + (SLOT_BAL ? CV_O + CV_UP / 4 : 0);
__device__ __forceinline__ CvItem cv_decode(const WSrc& W, bf16* Wb, int it) {
    bf16* W0 = Wb; bf16* W1 = Wb + W_LAYER / 2; int r = it;
    if (r < CV_QKV) return CvItem{W.w_qkv_a, W.n_attn_pre, W0, D, NQKV, 0, r, 0.f, nullptr, 0}; r -= CV_QKV;
    if (r < CV_O)   return CvItem{W.w_o_a, nullptr, W0 + W_QKV / 2, D, D, 0, r, 0.f, nullptr, 0}; r -= CV_O;
    if (r < CV_UP)  return CvItem{W.w_up, W.n_mlp_pre, W0 + (W_QKV + W_O) / 2, D, FF, 0, r, 0.f, I8_UP0 ? W.cmax + FF : nullptr, I8_UP0}; r -= CV_UP;
    if (r < CV_DN)  return CvItem{W.w_down, nullptr, W0 + (W_QKV + W_O + W_UP) / 2, FF, D, 0, r, 0.f, nullptr, 0}; r -= CV_DN;
    if (r < CV_O)   return CvItem{W.w_q_b, W.n_attn_pre + D, W1, D, D, 0, r, 0.f, nullptr, 0}; r -= CV_O;
    if (r < CV_KV)  return CvItem{W.w_kv, W.kv_norm, W1, D, 512, 2048, r, 0.f, nullptr, 0}; r -= CV_KV;
    if (r < CV_O)   return CvItem{W.w_o_b, nullptr, W1 + W_QKV / 2, D, D, 0, r, 0.f, nullptr, 0}; r -= CV_O;
    if (r < CV_UP)  return CvItem{W.w_up + (size_t)D * FF, W.n_mlp_pre + D, W1 + (W_QKV + W_O) / 2, D, FF, 0, r, 0.f, (I8_UP1 && I8_TEST != 2) ? W.cmax : nullptr, (I8_UP1 && I8_TEST != 2) ? 1 : 0}; r -= CV_UP;
    if (r < CV_DN)  return CvItem{W.w_down + (size_t)FF * D, nullptr, W1 + (W_QKV + W_O + W_UP) / 2, FF, D, 0, r, FP8_DOWN1 ? pg8::FP8_WSCALE : 0.f, nullptr, 0}; r -= CV_DN;
    if (r < CV_UP)  return CvItem{W.w_up + (size_t)D * FF, W.n_mlp_pre + D, nullptr, D, FF, 0, r, 0.f, W.cmax, 0}; r -= CV_UP;
    return CvItem{W.w_up, W.n_mlp_pre, nullptr, D, FF, 0, r, 0.f, W.cmax + FF, 0};
    return CvItem{W.w_down + (size_t)FF * D, nullptr, W1 + (W_QKV + W_O + W_UP) / 2, FF, D, 0, r, FP8_DOWN1 ? pg8::FP8_WSCALE : 0.f, nullptr, 0};
}
__device__ __forceinline__ void convert_weights(const WSrc& W, bf16* Wb, int it0, int it1, int gw, int NGW, LAS unsigned char* ldsbase, int wave, int lane_unused, int x0 = 0, int xn = 0) {
    const int lane = pg8::lane_now();
    LAS float* scr = (LAS float*)(ldsbase + wave * 16384);
    const int n1 = it1 - it0, ntot = n1 + xn;
#define CV_ID(k_) ((k_) < n1 ? it0 + (k_) : x0 + ((k_) - n1))
    int it = gw; if (it >= ntot) return;
    CvItem cur = cv_decode(W, Wb, CV_ID(it)); f32x4 va[8], vb[8];
    cv_load(cur, va, lane);
    for (;;) {
        const int nx = it + NGW; const bool more = nx < ntot; CvItem nxt = cur;
        if (more) { nxt = cv_decode(W, Wb, CV_ID(nx)); cv_load(nxt, vb, lane); }
        cv_finish(cur, va, scr, lane);
        if (!more) break;
#pragma unroll
        for (int i = 0; i < 8; ++i) va[i] = vb[i];
        cur = nxt; it = nx;
    }
#undef CV_ID
}
struct LayerCtx { const WSrc* W; float* RS; const float* x; float* out; const float* sinks_a; const float* n_attn_post; const float* n_mlp_post; bf16* Wb; bf16* QO; bf16* HB; bf16* XN; bf16* KB; bf16* VT; float* KMEAN; int lo, hi; };
#define GRID_BAR() do { if (N_LAUNCHES == 1) xcd_barrier(bar); } while (0)
#define GEMM_SKEW(N_) do { if ((N_) > 0) { const int g_ = F.vcu & 3; for (int i_ = 0; i_ < g_; ++i_) __builtin_amdgcn_s_sleep(N_); } } while (0)
#define IN(k) (lo <= (k) && (k) < hi)
#define BOTH(k) (IN(k) && IN((k) + 1))
#ifndef MLP_SPLIT1
#define MLP_SPLIT1 0
#endif
#ifndef MLP_SPLIT
#define MLP_SPLIT 1
#endif
template <int HALF_, int L_>
__device__ __forceinline__ void mlp_half_l0(Frame& F, const XcdBarrier& bar, const float* RS, const signed char* XQ, bf16* Wup, const unsigned* cmx, bf16* HB, bf16* Wdn, bf16* YB) {
    constexpr int MH = M / 2; const size_t r0 = (size_t)HALF_ * MH;
    {
        pg8::StaticOrder S; S.init(MH, FF, F.G, (int)blockIdx.x);
        { pg8::Unit pu; LAS float* rsl = (LAS float*)(F.lds + RSL_OFF); LAS float* cml = (LAS float*)(F.lds + CML_OFF);
          int tl_ = pg8::wave_tid(F.wave); asm volatile("" : "+v"(tl_));
          for (int i0 = 0; i0 < 8; i0 += 2) { const int i = i0 + (tl_ >> 8); if (S.next(i, pu)) { rsl[i * 256 + (tl_ & 255)] = RS[r0 + pu.pm * 256 + (tl_ & 255)];
              cml[i * 256 + (tl_ & 255)] = __builtin_bit_cast(float, cmx[pu.pn * 256 + (tl_ & 255)]) * (1.0f / 127.0f); } }
          __syncthreads(); }
        pg8::Gemm g8{(const pg8::bf16_t*)(XQ + r0 * D), Wup, MH, FF, D / 2};
        if constexpr (L_ == 0) {
        pg8::EpiBf16<2, false, H_BLK> E{HB + r0 * FF, FF, (const LAS float*)(F.lds + RSL_OFF), 1.0f, cmx, (const LAS float*)(F.lds + CML_OFF)};
        pg8::gemm_phase<pg8::EpiBf16<2, false, H_BLK>, pg8::StaticOrder, PG8_ALIGN, PG8_SP2, false, true, 0, W_LIN>(F.lds + RING_OFF, g8, S, E, F.wave);
        } else {
        pg8::EpiBf16<3, false, H_BLK> E{(bf16*)((unsigned char*)HB + r0 * FF), FF, (const LAS float*)(F.lds + RSL_OFF), 1.0f, cmx, (const LAS float*)(F.lds + CML_OFF)};
        pg8::gemm_phase<pg8::EpiBf16<3, false, H_BLK>, pg8::StaticOrder, PG8_ALIGN, PG8_SP2, false, true, 0, W_LIN>(F.lds + RING_OFF, g8, S, E, F.wave);
        }
        GRID_BAR();
    }
    {
        pg8::StaticOrder S; S.init(MH, D, F.G, (int)blockIdx.x);
        if constexpr (L_ == 0) {
        pg8::Gemm g{HB + r0 * FF, Wdn, MH, D, FF};
        pg8::EpiBf16<0, false, Y_BLK> E{YB + r0 * D, D, nullptr, 1.0f, nullptr};
        pg8::gemm_phase<pg8::EpiBf16<0, false, Y_BLK>, pg8::StaticOrder, PG8_ALIGN, PG8_SP2, false, false, H_BLK == 2 ? -1 : H_BLK ? 512 : 0, W_LIN>(F.lds + RING_OFF, g, S, E, F.wave);
        } else {
        pg8::Gemm g{(bf16*)((unsigned char*)HB + r0 * FF), Wdn, MH, D, FF / 2};
        pg8::EpiBf16<0, false, Y_BLK> E{YB + r0 * D, D, nullptr, 1.0f / (pg8::FP8_HSCALE * pg8::FP8_WSCALE), nullptr};
        pg8::gemm_phase<pg8::EpiBf16<0, false, Y_BLK>, pg8::StaticOrder, PG8_ALIGN, PG8_SP2, true, false, H_BLK == 2 ? -1 : H_BLK ? 256 : 0, W_LIN>(F.lds + RING_OFF, g, S, E, F.wave);
        }
        GRID_BAR();
    }
}
template <int l>
__device__ __forceinline__ void layer_phases(Frame& F, const XcdBarrier& bar, const LayerCtx& C) {
    const WSrc& W = *C.W; float* RS = C.RS; const float* x = C.x; float* out = C.out; const float* sinks_a = C.sinks_a; const float* n_attn_post = C.n_attn_post; const float* n_mlp_post = C.n_mlp_post;
    bf16* Wb = C.Wb; bf16* QO = C.QO; bf16* HB = C.HB; bf16* XN = C.XN; bf16* KB = C.KB; bf16* VT = C.VT; float* KMEAN = C.KMEAN; const int lo = C.lo, hi = C.hi;
        const int pb = 1 + 7 * l;
        bf16* WL = Wb + (size_t)l * (W_LAYER / 2);
        bf16* Wqkv = WL; bf16* Wo = WL + W_QKV / 2; bf16* Wup = WL + (W_QKV + W_O) / 2; bf16* Wdn = WL + (W_QKV + W_O + W_UP) / 2;
        bf16* YB = (l == 0) ? (bf16*)out : Wb;
        if (IN(pb)) {
            pg8::Gemm g{XN, Wqkv, M, NQKV, D}; pg8::StaticOrder S; S.init(M, NQKV, F.G, (int)blockIdx.x);
            { pg8::Unit pu; LAS float* rsl = (LAS float*)(F.lds + RSL_OFF);
              int tl_ = pg8::wave_tid(F.wave); asm volatile("" : "+v"(tl_));
              for (int i0 = 0; i0 < 8; i0 += 2) { const int i = i0 + (tl_ >> 8); if (S.next(i, pu)) rsl[i * 256 + (tl_ & 255)] = RS[pu.pm * 256 + (tl_ & 255)]; }
              __syncthreads(); }
            pg8::EpiQKV E{QO, KB, KMEAN, l, QSCALE, (const LAS float*)(F.lds + RSL_OFF)};
            GEMM_SKEW(SKEW_QKV);
            if (PROBE_DUP == 2 && l == 0) { pg8::gemm_phase<pg8::EpiQKV, pg8::StaticOrder, PG8_ALIGN, PG8_SP2, false, false, 0, W_LIN>(F.lds + RING_OFF, g, S, E, F.wave); __syncthreads(); }
            pg8::gemm_phase<pg8::EpiQKV, pg8::StaticOrder, PG8_ALIGN, PG8_SP2, false, false, 0, W_LIN>(F.lds + RING_OFF, g, S, E, F.wave);
            {
                constexpr int CV_D0 = CV_QKV + CV_O + CV_UP;
                const int c0 = (l == 0) ? CV_P0 : CV_P1, c1 = (l == 0) ? ((SLOT_DN0 && !SLOT_MOVE) ? CV_D0 : CV_P1) : CV_ALL;
                const int nshort = (int)F.G - (M / 256 * (NQKV / 256)) % (int)F.G, sb = (int)blockIdx.x - ((int)F.G - nshort);
                const int xn = (SLOT_MOVE && I8_UP1 && l == 0) ? CV_UP : (SLOT_DN0 && l == 0) ? CV_P1 - CV_L0 : 0;
                const int x0 = (SLOT_DN0 && !SLOT_MOVE && l == 0) ? CV_L0 : CV_ALL;
                if (nshort < (int)F.G && sb >= 0) convert_weights(W, Wb, c0, c1, sb * NWAVES + F.wave, nshort * NWAVES, F.lds + RING_OFF, F.wave, F.lane, x0, xn);
                else if (nshort == (int)F.G) convert_weights(W, Wb, c0, c1, (int)blockIdx.x * NWAVES + F.wave, (int)F.G * NWAVES, F.lds + RING_OFF, F.wave, F.lane, x0, xn);
                VM_WAIT(); __syncthreads();
            }
            if (BOTH(pb)) GRID_BAR();
        }
        if (IN(pb + 1)) {
            if (PROBE_DUP == 3 + 3 * l) { if (l == 0) attn_phase<0>(F, QO, HB + (size_t)M * D, KB, VT, nullptr, KMEAN + 64 * 256 + 64 * l, sinks_a); else attn_phase<1, PROBE_EXPT>(F, QO, HB + (size_t)M * D, KB, VT, KMEAN, KMEAN + 64 * 256 + 64 * l, nullptr); __syncthreads(); }
            if (l == 0) attn_phase<0>(F, QO, QO, KB, VT, nullptr, KMEAN + 64 * 256 + 64 * l, sinks_a);
            else        attn_phase<1>(F, QO, QO, KB, VT, KMEAN, KMEAN + 64 * 256 + 64 * l, nullptr);
            if (BOTH(pb + 1)) GRID_BAR();
        }
        if (IN(pb + 2)) {
            pg8::Gemm g{QO, Wo, M, D, D}; pg8::StaticOrder S; S.init(M, D, F.G, (int)blockIdx.x);
            pg8::EpiBf16<0, false, Y_BLK> E{YB, D, nullptr, 1.0f, nullptr};
            GEMM_SKEW(SKEW_O);
            if (PROBE_DUP == 8 && l == 0) { pg8::gemm_phase<pg8::EpiBf16<0, false, Y_BLK>, pg8::StaticOrder, PG8_ALIGN, PG8_SP2, false, false, QO_BLK ? 512 : 0, W_LIN, false>(F.lds + RING_OFF, g, S, E, F.wave);     __syncthreads(); }
            pg8::gemm_phase<pg8::EpiBf16<0, false, Y_BLK>, pg8::StaticOrder, PG8_ALIGN, PG8_SP2, false, false, QO_BLK ? 512 : 0, W_LIN, false>(F.lds + RING_OFF, g, S, E, F.wave);
            if (BOTH(pb + 2)) GRID_BAR();
        }
        if (IN(pb + 3)) {
            thin_phase<false>(F, YB, nullptr, XN, RS, nullptr, n_attn_post + l * D, ((I8_UP1 && I8_TEST != 1 && l == 1) || (I8_UP0 && l == 0)) ? (signed char*)out + XQ_OFF : nullptr);
            if (BOTH(pb + 3)) GRID_BAR();
        }
        constexpr bool split = N_LAUNCHES == 1 && PROBE_DUP == 0 && ((MLP_SPLIT && l == 0 && I8_UP0) || (MLP_SPLIT1 && l == 1 && FP8_DOWN1 && I8_UP1 && I8_TEST == 0));
        if constexpr (split) {
            mlp_half_l0<0, l>(F, bar, RS, (const signed char*)out + XQ_OFF, Wup, (const unsigned*)W.cmax + (l == 0 ? FF : 0), HB, Wdn, YB);
            mlp_half_l0<1, l>(F, bar, RS, (const signed char*)out + XQ_OFF, Wup, (const unsigned*)W.cmax + (l == 0 ? FF : 0), HB, Wdn, YB);
        }
        if (!split && IN(pb + 4)) {
            pg8::Gemm g{XN, Wup, M, FF, D}; pg8::StaticOrder S; S.init(M, FF, F.G, (int)blockIdx.x);
            const unsigned* const cmx = (FP8_DOWN1 && I8_UP1 && I8_TEST == 0 && l == 1) ? (const unsigned*)W.cmax : (I8_UP0 && l == 0) ? (const unsigned*)W.cmax + FF : nullptr;
            { pg8::Unit pu; LAS float* rsl = (LAS float*)(F.lds + RSL_OFF); LAS float* cml = (LAS float*)(F.lds + CML_OFF);
              int tl_ = pg8::wave_tid(F.wave); asm volatile("" : "+v"(tl_));
              for (int i0 = 0; i0 < 8; i0 += 2) { const int i = i0 + (tl_ >> 8); if (S.next(i, pu)) { rsl[i * 256 + (tl_ & 255)] = RS[pu.pm * 256 + (tl_ & 255)];
                  if (cmx) cml[i * 256 + (tl_ & 255)] = __builtin_bit_cast(float, cmx[pu.pn * 256 + (tl_ & 255)]) * (1.0f / 127.0f); } }
              __syncthreads(); }
            GEMM_SKEW(SKEW_UP);
            if (FP8_DOWN1 && I8_UP1 && I8_TEST == 0 && l == 1) {
                pg8::Gemm g8{(const pg8::bf16_t*)((const signed char*)out + XQ_OFF), Wup, M, FF, D / 2};
                pg8::EpiBf16<3, false, H_BLK> E{HB, FF, (const LAS float*)(F.lds + RSL_OFF), 1.0f, (const unsigned*)W.cmax, (const LAS float*)(F.lds + CML_OFF)};
                pg8::gemm_phase<pg8::EpiBf16<3, false, H_BLK>, pg8::StaticOrder, PG8_ALIGN, PG8_SP2, false, true, 0, W_LIN>(F.lds + RING_OFF, g8, S, E, F.wave);
            } else if (I8_UP0 && l == 0) {
                pg8::Gemm g8{(const pg8::bf16_t*)((const signed char*)out + XQ_OFF), Wup, M, FF, D / 2};
                pg8::EpiBf16<2, false, H_BLK> E{HB, FF, (const LAS float*)(F.lds + RSL_OFF), 1.0f, (const unsigned*)W.cmax + FF, (const LAS float*)(F.lds + CML_OFF)};
                if (PROBE_DUP == 15) { pg8::gemm_phase<pg8::EpiBf16<2, false, H_BLK>, pg8::StaticOrder, PG8_ALIGN, PG8_SP2, false, true, 0, W_LIN>(F.lds + RING_OFF, g8, S, E, F.wave); __syncthreads(); }
                if (PROBE_DUP == 17) { pg8::EpiBf16<2, true> EN{HB, FF, (const LAS float*)(F.lds + RSL_OFF), 1.0f, (const unsigned*)W.cmax + FF}; pg8::gemm_phase<pg8::EpiBf16<2, true>, pg8::StaticOrder, PG8_ALIGN, PG8_SP2, false, true, 0, W_LIN>(F.lds + RING_OFF, g8, S, EN, F.wave); __syncthreads(); }
                if (PROBE_DUP == 18) { pg8::EpiBf16<2, false, true> EN{HB, FF, (const LAS float*)(F.lds + RSL_OFF), 1.0f, (const unsigned*)W.cmax + FF}; pg8::gemm_phase<pg8::EpiBf16<2, false, true>, pg8::StaticOrder, PG8_ALIGN, PG8_SP2, false, true, 0, W_LIN>(F.lds + RING_OFF, g8, S, EN, F.wave); __syncthreads(); }
                if (PROBE_DUP == 19) { pg8::EpiBf16<2, false, true, true> EN{HB, FF, (const LAS float*)(F.lds + RSL_OFF), 1.0f, (const unsigned*)W.cmax + FF}; pg8::gemm_phase<pg8::EpiBf16<2, false, true, true>, pg8::StaticOrder, PG8_ALIGN, PG8_SP2, false, true, 0, W_LIN>(F.lds + RING_OFF, g8, S, EN, F.wave); __syncthreads(); }
                if (PROBE_DUP == 21) { pg8::EpiBf16<2, false, true, false, true> EN{HB, FF, (const LAS float*)(F.lds + RSL_OFF), 1.0f, (const unsigned*)W.cmax + FF}; pg8::gemm_phase<pg8::EpiBf16<2, false, true, false, true>, pg8::StaticOrder, PG8_ALIGN, PG8_SP2, false, true, 0, W_LIN>(F.lds + RING_OFF, g8, S, EN, F.wave); __syncthreads(); }
                if (PROBE_DUP == 22) { pg8::EpiBf16<2, false, true, true, true> EN{HB, FF, (const LAS float*)(F.lds + RSL_OFF), 1.0f, (const unsigned*)W.cmax + FF}; pg8::gemm_phase<pg8::EpiBf16<2, false, true, true, true>, pg8::StaticOrder, PG8_ALIGN, PG8_SP2, false, true, 0, W_LIN>(F.lds + RING_OFF, g8, S, EN, F.wave); __syncthreads(); }
                if (PROBE_DUP == 23) { pg8::EpiNull EN; pg8::gemm_phase<pg8::EpiNull, pg8::StaticOrder, PG8_ALIGN, PG8_SP2, false, true, -1, true>(F.lds + RING_OFF, g8, S, EN, F.wave); __syncthreads(); }
                if (PROBE_DUP == 24) { pg8::EpiNull EN; pg8::gemm_phase<pg8::EpiNull, pg8::StaticOrder, PG8_ALIGN, PG8_SP2, false, true, 0, true>(F.lds + RING_OFF, g8, S, EN, F.wave); __syncthreads(); }
                if (PROBE_DUP == 25) { pg8::EpiNull EN; pg8::gemm_phase<pg8::EpiNull, pg8::StaticOrder, PG8_ALIGN, PG8_SP2, false, true, -1, W_LIN>(F.lds + RING_OFF, g8, S, EN, F.wave); __syncthreads(); }
                if (PROBE_DUP == 16) { pg8::EpiNull EN; pg8::gemm_phase<pg8::EpiNull, pg8::StaticOrder, PG8_ALIGN, PG8_SP2, false, true, 0, W_LIN>(F.lds + RING_OFF, g8, S, EN, F.wave); __syncthreads(); }
                pg8::gemm_phase<pg8::EpiBf16<2, false, H_BLK>, pg8::StaticOrder, PG8_ALIGN, PG8_SP2, false, true, 0, W_LIN>(F.lds + RING_OFF, g8, S, E, F.wave);
            } else if (FP8_DOWN1 && l == 1) {
                pg8::EpiBf16<3, false, H_BLK> E{HB, FF, (const LAS float*)(F.lds + RSL_OFF), 1.0f, nullptr};
                pg8::gemm_phase<pg8::EpiBf16<3, false, H_BLK>, pg8::StaticOrder, PG8_ALIGN, PG8_SP2, false, false, 0, W_LIN>(F.lds + RING_OFF, g, S, E, F.wave);
            } else {
            pg8::EpiBf16<2, false, H_BLK> E{HB, FF, (const LAS float*)(F.lds + RSL_OFF), 1.0f, nullptr};
            if (PROBE_DUP == 5 && l == 0) { pg8::gemm_phase<pg8::EpiBf16<2, false, H_BLK>, pg8::StaticOrder, PG8_ALIGN, PG8_SP2, false, false, 0, W_LIN>(F.lds + RING_OFF, g, S, E, F.wave); __syncthreads(); }
            if (PROBE_DUP == 9 && l == 0) { pg8::SameTileOrder S2; S2.init(M, FF, F.G, (int)blockIdx.x); pg8::gemm_phase<pg8::EpiBf16<2, false, H_BLK>, pg8::SameTileOrder, PG8_ALIGN, PG8_SP2, false, false, 0, W_LIN>(F.lds + RING_OFF, g, S2, E, F.wave); __syncthreads(); }
            pg8::gemm_phase<pg8::EpiBf16<2, false, H_BLK>, pg8::StaticOrder, PG8_ALIGN, PG8_SP2, false, false, 0, W_LIN>(F.lds + RING_OFF, g, S, E, F.wave);
            }
            if (BOTH(pb + 4)) GRID_BAR();
        }
        if (!split && IN(pb + 5)) {
            pg8::StaticOrder S; S.init(M, D, F.G, (int)blockIdx.x);
            GEMM_SKEW(SKEW_DN);
            if (FP8_DOWN1 && l == 1) {
                pg8::Gemm g{HB, Wdn, M, D, FF / 2};
                pg8::EpiBf16<0, false, Y_BLK> E{YB, D, nullptr, 1.0f / (pg8::FP8_HSCALE * pg8::FP8_WSCALE), nullptr};
                pg8::gemm_phase<pg8::EpiBf16<0, false, Y_BLK>, pg8::StaticOrder, PG8_ALIGN, PG8_SP2, true, false, H_BLK == 2 ? -1 : H_BLK ? 256 : 0, W_LIN>(F.lds + RING_OFF, g, S, E, F.wave);
            } else {
            pg8::Gemm g{HB, Wdn, M, D, FF};
            pg8::EpiBf16<0, false, Y_BLK> E{YB, D, nullptr, 1.0f, nullptr};
            if (PROBE_DUP == 7 && l == 0) { pg8::gemm_phase<pg8::EpiBf16<0, false, Y_BLK>, pg8::StaticOrder, PG8_ALIGN, PG8_SP2, false, false, H_BLK == 2 ? -1 : H_BLK ? 512 : 0, W_LIN>(F.lds + RING_OFF, g, S, E, F.wave); __syncthreads(); }
            pg8::gemm_phase<pg8::EpiBf16<0, false, Y_BLK>, pg8::StaticOrder, PG8_ALIGN, PG8_SP2, false, false, H_BLK == 2 ? -1 : H_BLK ? 512 : 0, W_LIN>(F.lds + RING_OFF, g, S, E, F.wave);
            }
            if (BOTH(pb + 5)) GRID_BAR();
        }
        if (IN(pb + 6)) {
            if (l == 0) thin_phase<false>(F, YB, nullptr, XN, RS, nullptr, n_mlp_post);
            else        thin_phase<true>(F, YB, nullptr, XN, nullptr, out, n_mlp_post + D);
            if (BOTH(pb + 6)) GRID_BAR();
        }
}
#undef IN
#undef BOTH
#undef GRID_BAR
#undef GEMM_SKEW
struct Args { const float* in[14]; float* out; unsigned char* ws; int ph_lo, ph_hi; };
__global__ void __launch_bounds__(NWAVES * 64, 2) yoco_fwd(Args args) {
    extern __shared__ __attribute__((aligned(16))) unsigned char lds[];
    Frame F;
    F.lds = (LAS unsigned char*)lds;
    F.MISC = (volatile LAS unsigned*)(F.lds + MISC_OFF);
    F.wave = __builtin_amdgcn_readfirstlane((int)threadIdx.x >> 6); F.tid = pg8::wave_tid(F.wave); F.lane = F.tid & 63;
    F.G = gridDim.x; { const int bx = blockIdx.x; F.vcu = (F.G % 8 == 0) ? (bx % 8) * (F.G / 8) + bx / 8 : bx; }
    unsigned char* ws = args.ws;
    F.ctl = (gu32*)(ws + WS_CTL);
    for (int u = F.tid; u < (LDS_BYTES - LDSCTL_OFF) / 4; u += NWAVES * 64) ((LAS unsigned*)(F.lds + LDSCTL_OFF))[u] = 0u;
    __syncthreads();
    XcdBarrier bar; bar.bar = (unsigned*)(F.ctl + CW_BAR); bar.x = 0; bar.st = nullptr; bar.w = (unsigned)F.wave;
    if (N_LAUNCHES == 1) bar = xcd_barrier_post((unsigned*)(F.ctl + CW_BAR), F.MISC + 8, (unsigned)F.wave);
#define GRID_BAR() do { if (N_LAUNCHES == 1) xcd_barrier(bar); } while (0)
    const int lo = args.ph_lo, hi = args.ph_hi;
#define IN(k) (lo <= (k) && (k) < hi)
#define BOTH(k) (IN(k) && IN((k) + 1))

    const float* x = args.in[0]; const float* w_qkv_a = args.in[1]; const float* sinks_a = args.in[2]; const float* w_o_a = args.in[3]; const float* kv_norm = args.in[4];
    const float* w_kv = args.in[5]; const float* w_q_b = args.in[6]; const float* w_o_b = args.in[7]; const float* n_attn_pre = args.in[8]; const float* n_attn_post = args.in[9];
    const float* n_mlp_pre = args.in[10]; const float* n_mlp_post = args.in[11]; const float* w_up = args.in[12]; const float* w_down = args.in[13];
    bf16* Wb = (bf16*)(ws + WS_W);
    bf16* QO = (bf16*)(ws + WS_QO); bf16* HB = (bf16*)(ws + WS_H); bf16* XN = (bf16*)(ws + WS_XN); bf16* KB = (bf16*)(ws + WS_K); bf16* VT = (bf16*)(ws + WS_VT);
    float* KMEAN = (float*)(ws + CTL_KMEAN); float* RS = (float*)(ws + WS_RS);
    float* out = args.out;

    const WSrc W{(unsigned*)(ws + CTL_CMAX), w_qkv_a, w_o_a, kv_norm, w_kv, w_q_b, w_o_b, n_attn_pre, n_mlp_pre, w_up, w_down};
    if (IN(0)) {
      for (int rep = 0; rep < (PROBE_DUP == 1 ? 2 : 1); ++rep) {
        const int gw = F.vcu * NWAVES + F.wave, NGW = F.G * NWAVES;
        if (I8_UP1) convert_weights(W, Wb, CV_ALL + (SLOT_MOVE ? CV_UP : 0), CV_ALL + (I8_UP0 ? 2 : 1) * CV_UP, gw, NGW, F.lds + RING_OFF, F.wave, F.lane);
        convert_weights(W, Wb, 0, CV_P0, gw, NGW, F.lds + RING_OFF, F.wave, F.lane, CV_QKV + CV_O + CV_UP, (SLOT_DN0 && !SLOT_MOVE) ? CV_DN : 0);
        { const int ln_ = pg8::lane_now(); for (int m = gw; m < M; m += NGW) rms_row_to_bf16(x + (size_t)m * D, XN + (size_t)m * D, RS + m, ln_); }
        VM_WAIT(); __syncthreads();
      }
        if (BOTH(0)) GRID_BAR();
    }
    { LayerCtx C{&W, RS, x, out, sinks_a, n_attn_post, n_mlp_post, Wb, QO, HB, XN, KB, VT, KMEAN, lo, hi};
      layer_phases<0>(F, bar, C);
      layer_phases<1>(F, bar, C); }
#undef IN
#undef BOTH
#undef GRID_BAR
}

extern "C" void kernel_launch(void* const* d_in, const int* in_sizes, int n_in, void* d_out, int out_size, void* d_ws, size_t ws_size, hipStream_t stream) {
    static int grid = 0;
    if (grid == 0) {
        if (n_in != 14 || in_sizes[0] != M * D || out_size != M * D || ws_size < WS_END) { fprintf(stderr, "kernel_launch: unexpected shapes / workspace (n_in %d, in0 %d, out %d, ws %zu < %zu)\n", n_in, n_in > 0 ? in_sizes[0] : -1, out_size, ws_size, (size_t)WS_END); grid = -1; return; }
        int dev = 0, cus = 0, per_cu = 0;
        if (hipGetDevice(&dev) != hipSuccess || hipDeviceGetAttribute(&cus, hipDeviceAttributeMultiprocessorCount, dev) != hipSuccess) { grid = -1; return; }
        if (hipFuncSetAttribute((const void*)yoco_fwd, hipFuncAttributeMaxDynamicSharedMemorySize, LDS_BYTES) != hipSuccess) { fprintf(stderr, "kernel_launch: hipFuncSetAttribute failed\n"); grid = -1; return; }
        if (hipOccupancyMaxActiveBlocksPerMultiprocessor(&per_cu, (const void*)yoco_fwd, NWAVES * 64, LDS_BYTES) != hipSuccess || per_cu < 1) { fprintf(stderr, "kernel_launch: occupancy query reports %d workgroups per CU\n", per_cu); }
        (void)hipGetLastError();
        grid = cus;
    }
    if (grid < 0) return;
    if (hipMemsetAsync((char*)d_ws + WS_CTL, 0, CTL_ZERO_BYTES, stream) != hipSuccess) return;
    Args a{};
    for (int i = 0; i < 14; ++i) a.in[i] = (const float*)d_in[i];
    a.out = (float*)d_out; a.ws = (unsigned char*)d_ws;
    if (N_LAUNCHES == 1) { a.ph_lo = 0; a.ph_hi = N_PHASES; hipLaunchKernelGGL(yoco_fwd, dim3(grid), dim3(NWAVES * 64), LDS_BYTES, stream, a); }
    else for (int p = 0; p < N_PHASES; ++p) { a.ph_lo = p; a.ph_hi = p + 1; hipLaunchKernelGGL(yoco_fwd, dim3(grid), dim3(NWAVES * 64), LDS_BYTES, stream, a); }
}
```

```cpp
#include <hip/hip_runtime.h>
#include <cstdio>
#include <cstdint>
#ifndef V_ST8
#define V_ST8 0
#endif
#ifndef AT_VTR
#define AT_VTR 0
#endif
#ifndef QO_BLK
#define QO_BLK 1
#endif
#ifndef PG8_WT
#define PG8_WT 0
#endif
#ifndef PG8_SLACK
#define PG8_SLACK 0
#endif
#ifndef PG8_B_AUX
#define PG8_B_AUX 0
#endif
#ifndef PG8_H_NT
#define PG8_H_NT 0
#endif
namespace pg8 {
#define PG8_LAS __attribute__((address_space(3)))
typedef unsigned short bf16_t;
typedef short bf16x8 __attribute__((ext_vector_type(8)));
typedef float f32x4 __attribute__((ext_vector_type(4)));
typedef unsigned u32x4 __attribute__((ext_vector_type(4)));
__device__ __forceinline__ int lane_now() { int l; asm volatile("v_mbcnt_lo_u32_b32 %0, -1, 0\n\tv_mbcnt_hi_u32_b32 %0, -1, %0" : "=v"(l)); return l; }
__device__ __forceinline__ int wave_tid(int wave) { return (wave << 6) | lane_now(); }
constexpr int BM = 256, BK = 64, HALF = 128, HTB = HALF * BK * 2  , STAGE_BYTES = 8 * HTB, NXCD = 8, WGM = 8;

__host__ __device__ __forceinline__ int lds_byte(int r, int c) { const int st = (r >> 4) * 2 + (c >> 5), rr = r & 15, cc = c & 31, ob = rr * 64 + cc * 2; return st * 1024 + (ob ^ (((ob >> 9) & 1) << 5)); }
__host__ __device__ __forceinline__ void stage_rc(int b, int& R, int& C) { const int st = b / 1024, sb = b % 1024, swz = sb ^ (((sb >> 9) & 1) << 5); R = (st >> 1) * 16 + swz / 64; C = (st & 1) * 32 + (swz % 64) / 2; }
__host__ __device__ __forceinline__ int perm32(int rho) { const int n = rho >> 4, i = rho & 15; return 8 * (i >> 2) + 4 * n + (i & 3); }

struct Unit { int pm, pn, ui; };
struct Gemm { const bf16_t* A; const bf16_t* Bt; int M, N, K; };

struct StaticOrder {
    int nM, nN, nwg, G, c;
    __host__ __device__ void init(int M, int N, int G_, int c_) { nM = M / BM; nN = N / BM; nwg = nM * nN; G = G_; c = c_; }
    __host__ __device__ bool next(int i, Unit& u) const {
        const long L = (long)i * G + c; if (L >= nwg) return false;
        int wgid = (int)L; { const int q = nwg / NXCD, r = nwg % NXCD, xcd = wgid % NXCD, off = wgid / NXCD; wgid = (xcd < r ? xcd * (q + 1) : r * (q + 1) + (xcd - r) * q) + off; }
        const int nig = WGM * nN, gid = wgid / nig, fm = gid * WGM, gsz = (nM - fm) < WGM ? (nM - fm) : WGM;
        u.pm = fm + ((wgid % nig) % gsz); u.pn = (wgid % nig) / gsz; u.ui = i; return true;
    }
    __device__ __forceinline__ void a_ready(const Unit&) const {}
    __device__ __forceinline__ void done(const Unit&) const {}
};

struct SameTileOrder { StaticOrder S; __host__ __device__ void init(int M, int N, int G_, int c_) { S.init(M, N, G_, c_); }
    __host__ __device__ bool next(int i, Unit& u) const { const bool ok = S.next(i, u); u.pm = 0; u.pn = 0; return ok; }
    __device__ __forceinline__ void a_ready(const Unit&) const {} __device__ __forceinline__ void done(const Unit&) const {} };
__device__ __forceinline__ unsigned cvt_pk_bf16(float lo, float hi) { unsigned r; asm volatile("v_cvt_pk_bf16_f32 %0, %1, %2" : "=v"(r) : "v"(lo), "v"(hi)); return r; }
#if PG8_WT
#define PG8_ST16(p_, v_) asm volatile("global_store_dwordx4 %0, %1, off sc1\n\ts_nop 1" :: "v"(p_), "v"(v_) : "memory")
#else
#define PG8_ST16(p_, v_) (*(u32x4*)(p_) = (v_))
#endif
__device__ __forceinline__ unsigned pk_fp8x4(float a, float b, float c, float d) {
    a = __builtin_fminf(__builtin_fmaxf(a, -448.f), 448.f); b = __builtin_fminf(__builtin_fmaxf(b, -448.f), 448.f); c = __builtin_fminf(__builtin_fmaxf(c, -448.f), 448.f); d = __builtin_fminf(__builtin_fmaxf(d, -448.f), 448.f);
    int w = 0; w = __builtin_amdgcn_cvt_pk_fp8_f32(a, b, w, false); w = __builtin_amdgcn_cvt_pk_fp8_f32(c, d, w, true); return (unsigned)w; }
constexpr float FP8_HSCALE = 16.0f, FP8_WSCALE = 256.0f;
template <int ACT  , bool NOSTORE = false  , int BLK = 0  , bool SAMEBLK = false  , bool LINEAR = false  > struct EpiBf16 {
    static constexpr bool PERM = true, AFTER_DRAIN = false; static constexpr int NST = NOSTORE ? 0 : 16;
    bf16_t* O; int ldc; const PG8_LAS float* rs; float cs; const unsigned* cmax; const PG8_LAS float* cml;
    __device__ __forceinline__ void operator()(const f32x4 (&acc)[2][2][4][2], const Unit& u, int wr, int wc, int fr_, int fq_) const {
        int fr = fr_, fq = fq_; asm volatile("" : "+v"(fr), "+v"(fq));
        const int row0 = u.pm * BM + wr * 64 + fr; const int col0 = u.pn * BM + wc * 32 + 8 * fq;
        float rsv[2][4];
#pragma unroll
        for (int ai = 0; ai < 2; ++ai)
#pragma unroll
            for (int m = 0; m < 4; ++m) rsv[ai][m] = rs ? rs[(u.ui & 7) * 256 + wr * 64 + fr + ai * HALF + m * 16] : 1.0f;
        f32x4 cv[2][2];
        if (cmax) {
#pragma unroll
            for (int bj = 0; bj < 2; ++bj)
#pragma unroll
                for (int n = 0; n < 2; ++n) {
                    if (cml) { cv[bj][n] = *(const PG8_LAS f32x4*)(cml + (u.ui & 7) * 256 + wc * 32 + 8 * fq + bj * HALF + 4 * n); continue; }
                    const u32x4 cw = *(const u32x4*)(cmax + col0 + bj * HALF + 4 * n);
                    cv[bj][n] = __builtin_bit_cast(f32x4, cw) * (1.0f / 127.0f); }
        }
#pragma unroll
        for (int ai = 0; ai < 2; ++ai)
#pragma unroll
            for (int m = 0; m < 4; ++m) { bf16_t* rowp = BLK == 2 ? O + (size_t)u.pm * 256 * ldc + ((u.pn * 4 + (wc >> 1)) * 32768 + ai * 16384 + ((wr * 4 + m) * 2 + (wc & 1)) * 1024 + ((fr * 64 + fq * 16) ^ ((fr >> 3) << 5))) / 2
                                        : BLK ? O + ((size_t)(u.pm * (ldc >> 8) + (SAMEBLK ? (u.pn & 3) : u.pn)) * 256 + wr * 64 + fr + ai * HALF + m * 16) * 256 + wc * 32 + 8 * fq : O + (size_t)(row0 + ai * HALF + m * 16) * ldc + col0;
                constexpr int BJSTEP = BLK == 2 ? 32768 : HALF;
#pragma unroll
                for (int bj = 0; bj < 2; ++bj) { f32x4 a0 = acc[ai][bj][m][0], a1 = acc[ai][bj][m][1];
                    if (cmax) { typedef int i32x4_ __attribute__((ext_vector_type(4)));
                        a0 = __builtin_convertvector(__builtin_bit_cast(i32x4_, acc[ai][bj][m][0]), f32x4) * cv[bj][0]; a1 = __builtin_convertvector(__builtin_bit_cast(i32x4_, acc[ai][bj][m][1]), f32x4) * cv[bj][1]; }
                    f32x4 v0 = a0 * (rsv[ai][m] * cs), v1 = a1 * (rsv[ai][m] * cs);
                    if (ACT == 3) {
#pragma unroll
                        for (int e = 0; e < 4; ++e) { const float a = fmaxf(v0[e], 0.f), b = fmaxf(v1[e], 0.f); v0[e] = a * a * FP8_HSCALE; v1[e] = b * b * FP8_HSCALE; }
                        typedef unsigned u32x2 __attribute__((ext_vector_type(2)));
                        u32x2 w8; w8.x = pk_fp8x4(v0[0], v0[1], v0[2], v0[3]); w8.y = pk_fp8x4(v1[0], v1[1], v1[2], v1[3]);
                        if (NOSTORE) { asm volatile("" :: "v"(w8)); continue; }
                        unsigned char* const p8 = BLK == 2 ? (unsigned char*)O + (size_t)u.pm * 256 * ldc + (u.pn * 2 + bj) * 32768 + ai * 16384 + ((wr * 4 + m) * 2 + (wc >> 1)) * 1024 + ((fr * 64 + (wc & 1) * 32 + fq * 8) ^ ((fr >> 3) << 5))
                                                  : BLK ? (unsigned char*)O + ((size_t)(u.pm * (ldc >> 8) + u.pn) * 256 + wr * 64 + fr + ai * HALF + m * 16) * 256 + wc * 32 + 8 * fq + bj * HALF
                                                      : (unsigned char*)O + (size_t)(row0 + ai * HALF + m * 16) * ldc + col0 + bj * HALF;
                        if (PG8_H_NT) __builtin_nontemporal_store(w8, (u32x2*)p8);
                        else *(u32x2*)p8 = w8;
                        continue; }
                    if (ACT == 2) {
#pragma unroll
                        for (int e = 0; e < 4; ++e) { const float a = fmaxf(v0[e], 0.f), b = fmaxf(v1[e], 0.f); v0[e] = a * a; v1[e] = b * b; } }
                    u32x4 w; w.x = cvt_pk_bf16(v0[0], v0[1]); w.y = cvt_pk_bf16(v0[2], v0[3]); w.z = cvt_pk_bf16(v1[0], v1[1]); w.w = cvt_pk_bf16(v1[2], v1[3]);
                    if (NOSTORE) { asm volatile("" :: "v"(w)); continue; }
                    if (LINEAR) { *(u32x4*)(O + (size_t)(u.pm * (ldc >> 8) + (SAMEBLK ? (u.pn & 3) : u.pn)) * 65536 + ((wr * 4 + wc) * 16 + (ai * 4 + m) * 2 + bj) * 512 + (fr + 16 * fq) * 8) = w; continue; }
                    if (ACT == 2 && PG8_H_NT) __builtin_nontemporal_store(w, (u32x4*)(rowp + bj * BJSTEP));
                    else PG8_ST16(rowp + bj * BJSTEP, w); } }
    }
};
struct EpiQKV {
    static constexpr bool PERM = true, AFTER_DRAIN = false; static constexpr int NST = 0;
    bf16_t* Q; bf16_t* Kb; float* kmbase; int layer; float qscale; const PG8_LAS float* rs;
    __device__ __forceinline__ void operator()(const f32x4 (&acc)[2][2][4][2], const Unit& u, int wr, int wc, int fr_, int fq_) const {
        int fr = fr_, fq = fq_; asm volatile("" : "+v"(fr), "+v"(fq));
        const int row0 = u.pm * BM + wr * 64 + fr;
        bf16_t* const Vt = Kb + (size_t)16384 * 256; float* const kmean = layer ? kmbase : nullptr; float* const kmaxp = kmbase + 64 * 256 + 64 * layer;
        float rsv[2][4];
#pragma unroll
        for (int ai = 0; ai < 2; ++ai)
#pragma unroll
            for (int m = 0; m < 4; ++m) rsv[ai][m] = rs[(u.ui & 7) * 256 + wr * 64 + fr + ai * HALF + m * 16];
        if (u.pn < 8) {
            const int col0 = u.pn * BM + wc * 32 + 8 * fq; const float sc = qscale;
#pragma unroll
            for (int ai = 0; ai < 2; ++ai)
#pragma unroll
                for (int m = 0; m < 4; ++m) { bf16_t* rowp = QO_BLK ? Q + ((size_t)(u.pm * 8 + u.pn) * 256 + wr * 64 + fr + ai * HALF + m * 16) * 256 + wc * 32 + 8 * fq : Q + (size_t)(row0 + ai * HALF + m * 16) * 2048 + col0;
#pragma unroll
                    for (int bj = 0; bj < 2; ++bj) { const float sr = sc * rsv[ai][m]; const f32x4 v0 = acc[ai][bj][m][0] * sr, v1 = acc[ai][bj][m][1] * sr;
                        u32x4 w; w.x = cvt_pk_bf16(v0[0], v0[1]); w.y = cvt_pk_bf16(v0[2], v0[3]); w.z = cvt_pk_bf16(v1[0], v1[1]); w.w = cvt_pk_bf16(v1[2], v1[3]);
                        PG8_ST16(rowp + bj * HALF, w); } }
        } else if (u.pn == 8) {
            const int col0 = wc * 32 + 8 * fq;
#pragma unroll
            for (int ai = 0; ai < 2; ++ai)
#pragma unroll
                for (int m = 0; m < 4; ++m) { bf16_t* rowp = Kb + (size_t)(row0 + ai * HALF + m * 16) * 256 + col0;
#pragma unroll
                    for (int bj = 0; bj < 2; ++bj) { const f32x4 v0 = acc[ai][bj][m][0] * rsv[ai][m], v1 = acc[ai][bj][m][1] * rsv[ai][m];
                        u32x4 w; w.x = cvt_pk_bf16(v0[0], v0[1]); w.y = cvt_pk_bf16(v0[2], v0[3]); w.z = cvt_pk_bf16(v1[0], v1[1]); w.w = cvt_pk_bf16(v1[2], v1[3]);
                        PG8_ST16(rowp + bj * HALF, w); } }
            __builtin_amdgcn_sched_barrier(0);
            {
#pragma unroll
                for (int bj = 0; bj < 2; ++bj) { float mx = 0.f;
#pragma unroll
                    for (int ai = 0; ai < 2; ++ai)
#pragma unroll
                        for (int m = 0; m < 4; ++m) { float ps = 0.f;
#pragma unroll
                            for (int n = 0; n < 2; ++n)
#pragma unroll
                                for (int e = 0; e < 4; ++e) { const float kv = acc[ai][bj][m][n][e] * rsv[ai][m]; ps = __builtin_fmaf(kv, kv, ps); }
                            ps += __shfl_xor(ps, 16); ps += __shfl_xor(ps, 32); mx = fmaxf(mx, ps); }
                    mx = fmaxf(mx, __shfl_xor(mx, 1)); mx = fmaxf(mx, __shfl_xor(mx, 2)); mx = fmaxf(mx, __shfl_xor(mx, 4)); mx = fmaxf(mx, __shfl_xor(mx, 8));
                    __builtin_amdgcn_sched_barrier(0);
                    if (fr == 0 && fq == 0) __hip_atomic_fetch_max((unsigned*)kmaxp + (((u.pm >> 4) * 4 + 2 * bj + (wc >> 1)) * 2 + (wc & 1)), __builtin_bit_cast(unsigned, mx), __ATOMIC_RELAXED, __HIP_MEMORY_SCOPE_AGENT); }
            }
            __builtin_amdgcn_sched_barrier(0);
            if (kmean) {
                float* km = kmean + (size_t)u.pm * 256 + col0;
#pragma unroll
                for (int bj = 0; bj < 2; ++bj)
#pragma unroll
                    for (int n = 0; n < 2; ++n)
#pragma unroll
                        for (int e = 0; e < 4; ++e) { float s = 0.f;
#pragma unroll
                            for (int ai = 0; ai < 2; ++ai)
#pragma unroll
                                for (int m = 0; m < 4; ++m) s += acc[ai][bj][m][n][e] * rsv[ai][m];
                            s += __shfl_xor(s, 1); s += __shfl_xor(s, 2); s += __shfl_xor(s, 4); s += __shfl_xor(s, 8);
                            if (fr == 0) __hip_atomic_fetch_add(km + bj * HALF + 4 * n + e, s, __ATOMIC_RELAXED, __HIP_MEMORY_SCOPE_AGENT);
                            __builtin_amdgcn_sched_barrier(0); }
            }
        } else if (AT_VTR) {
            const int col0 = wc * 32 + 8 * fq;
#pragma unroll
            for (int ai = 0; ai < 2; ++ai)
#pragma unroll
                for (int m = 0; m < 4; ++m) { bf16_t* rowp = Vt + (size_t)(row0 + ai * HALF + m * 16) * 256 + col0;
#pragma unroll
                    for (int bj = 0; bj < 2; ++bj) { const f32x4 v0 = acc[ai][bj][m][0] * rsv[ai][m], v1 = acc[ai][bj][m][1] * rsv[ai][m];
                        u32x4 w; w.x = cvt_pk_bf16(v0[0], v0[1]); w.y = cvt_pk_bf16(v0[2], v0[3]); w.z = cvt_pk_bf16(v1[0], v1[1]); w.w = cvt_pk_bf16(v1[2], v1[3]);
                        PG8_ST16(rowp + bj * HALF, w); } }
        } else {
            if (V_ST8) {
                const int b = u.pm >> 4, tb4 = (u.pm & 15) * 256 + wr * 64 + (fr & ~3);
                const bool odd = (fr & 1) != 0, hi2 = (fr & 2) != 0;
#pragma unroll
                for (int ai = 0; ai < 2; ++ai)
#pragma unroll
                    for (int m = 0; m < 4; ++m)
#pragma unroll
                        for (int bj = 0; bj < 2; ++bj)
#pragma unroll
                            for (int n = 0; n < 2; ++n) { const f32x4 v = acc[ai][bj][m][n] * rsv[ai][m];
                                const float s0 = odd ? v[0] : v[2], s1 = odd ? v[1] : v[3];
                                const float r0 = __shfl_xor(s0, 1), r1 = __shfl_xor(s1, 1);
                                const unsigned w0 = odd ? cvt_pk_bf16(r0, v[2]) : cvt_pk_bf16(v[0], r0);
                                const unsigned w1 = odd ? cvt_pk_bf16(r1, v[3]) : cvt_pk_bf16(v[1], r1);
                                const unsigned snd = hi2 ? w0 : w1, rcv = (unsigned)__shfl_xor((int)snd, 2);
                                typedef unsigned u32x2_ __attribute__((ext_vector_type(2)));
                                u32x2_ o; o.x = hi2 ? rcv : w0; o.y = hi2 ? w1 : rcv;
                                const int cl = bj * HALF + wc * 32 + 8 * fq + 4 * n + (odd ? 2 : 0) + (hi2 ? 1 : 0);
                                const int kvh = cl >> 6, d = cl & 63;
                                *(u32x2_*)(Vt + ((size_t)((b * 4 + kvh) * 64 + d)) * 4096 + tb4 + ai * HALF + m * 16) = o; }
            } else {
            const int b = u.pm >> 4, tb = (u.pm & 15) * 256 + wr * 64 + (fr & ~1);
            const bool odd = (fr & 1) != 0;
#pragma unroll
            for (int ai = 0; ai < 2; ++ai)
#pragma unroll
                for (int m = 0; m < 4; ++m)
#pragma unroll
                    for (int bj = 0; bj < 2; ++bj)
#pragma unroll
                        for (int n = 0; n < 2; ++n) { const f32x4 v = acc[ai][bj][m][n] * rsv[ai][m];
                            const float s0 = odd ? v[0] : v[2], s1 = odd ? v[1] : v[3];
                            const float r0 = __shfl_xor(s0, 1), r1 = __shfl_xor(s1, 1);
                            const int cl = bj * HALF + wc * 32 + 8 * fq + 4 * n + (odd ? 2 : 0);
                            const int kvh = cl >> 6, d = cl & 63;
                            unsigned* p = (unsigned*)(Vt + ((size_t)((b * 4 + kvh) * 64 + d)) * 4096 + tb + ai * HALF + m * 16);
                            const unsigned w0 = odd ? cvt_pk_bf16(r0, v[2]) : cvt_pk_bf16(v[0], r0);
                            const unsigned w1 = odd ? cvt_pk_bf16(r1, v[3]) : cvt_pk_bf16(v[1], r1);
                            p[0] = w0; p[2048] = w1; }
            }
        }
    }
};
struct EpiNull {
    static constexpr bool PERM = true, AFTER_DRAIN = false; static constexpr int NST = 0;
    __device__ __forceinline__ void operator()(const f32x4 (&acc)[2][2][4][2], const Unit& u, int wr, int wc, int fr_, int fq_) const {
#pragma unroll
        for (int ai = 0; ai < 2; ++ai)
#pragma unroll
            for (int bj = 0; bj < 2; ++bj)
#pragma unroll
                for (int m = 0; m < 4; ++m)
#pragma unroll
                    for (int n = 0; n < 2; ++n) asm volatile("" :: "v"(acc[ai][bj][m][n]));
    }
};
typedef int pg8_v8i __attribute__((ext_vector_type(8)));
typedef int pg8_v4i __attribute__((ext_vector_type(4)));
__device__ __forceinline__ pg8_v8i pg8_cat(bf16x8 a, bf16x8 b) { const pg8_v4i x = __builtin_bit_cast(pg8_v4i, a), y = __builtin_bit_cast(pg8_v4i, b); return (pg8_v8i){x[0], x[1], x[2], x[3], y[0], y[1], y[2], y[3]}; }
template <class Epi, class Sched, bool ALIGN_EPI = false, bool SP2 = false, bool FP8 = false, bool I8 = false, int ALAY = 0, bool BLIN = false, bool SLK = true>
__device__ __forceinline__ void gemm_phase(PG8_LAS unsigned char* lds, const Gemm g, const Sched& S, const Epi& E, const int wave_) {
    const int tid = wave_tid(wave_), wid = wave_, lane = tid & 63, wr = wid >> 2, wc = wid & 3, fr = lane & 15, fq = lane >> 4;
    const int K = g.K, nt = K / BK;
    unsigned voffA[2], voffB[2];
#pragma unroll
    for (int i = 0; i < 2; ++i) { int R, C; stage_rc(tid * 16 + i * 8192, R, C); const int Rb = Epi::PERM ? ((R & ~31) + perm32(R & 31)) : R;
        voffA[i] = ALAY < 0 ? (unsigned)(tid * 16 + i * 8192) : ALAY > 0 ? (unsigned)(R * ALAY + C * 2) : (unsigned)(R * K + C) * 2u;
        voffB[i] = BLIN ? (unsigned)(tid * 16 + i * 8192) : (unsigned)(Rb * K + C) * 2u; }
    const size_t tstep = (size_t)2 * HALF * K * 2;
    const size_t kstepA = ALAY < 0 ? (size_t)32768 : (size_t)(BK * 2), kstepB = BLIN ? (size_t)32768 : (size_t)(BK * 2);
    const size_t hstepA = ALAY < 0 ? (size_t)16384 : ALAY > 0 ? (size_t)HALF * ALAY : (size_t)HALF * K * 2, hstepB = BLIN ? (size_t)16384 : (size_t)HALF * K * 2;
#define PG8_KOFFA(t_) (ALAY > 0 ? (size_t)((t_) / (ALAY / 128)) * (size_t)(256 * ALAY) + (size_t)((t_) % (ALAY / 128)) * 128 : (size_t)(t_) * kstepA)
    const unsigned ldsw = (unsigned)wid * 1024u;
    const int aoff = lds_byte(wr * 64 + fr, fq * 8), boff = lds_byte(wc * 32 + fr, fq * 8);
#define PG8_SA(b, h) (((b) * 2 + (h)) * HTB)
#define PG8_SB(b, h) ((4 + (b) * 2 + (h)) * HTB)
#define PG8_STAGE(bufoff, gbase, voff) do { _Pragma("unroll") for (int _i = 0; _i < 2; ++_i) \
        __builtin_amdgcn_global_load_lds((const unsigned*)((const char*)(gbase) + (voff)[_i]), (PG8_LAS unsigned*)(lds + (bufoff) + ldsw + _i * 8192), 16, 0, 0); } while (0)
#define PG8_STAGEB(bufoff, gbase, voff) do { _Pragma("unroll") for (int _i = 0; _i < 2; ++_i) \
        __builtin_amdgcn_global_load_lds((const unsigned*)((const char*)(gbase) + (voff)[_i]), (PG8_LAS unsigned*)(lds + (bufoff) + ldsw + _i * 8192), 16, 0, PG8_B_AUX); } while (0)
#define PG8_LDA(dst, b, h) do { _Pragma("unroll") for (int m = 0; m < 4; ++m) _Pragma("unroll") for (int k = 0; k < 2; ++k) dst[m][k] = *(const PG8_LAS bf16x8*)(lds + PG8_SA(b, h) + aoff + m * 2048 + k * 1024); } while (0)
#define PG8_LDB(dst, b, h) do { _Pragma("unroll") for (int n = 0; n < 2; ++n) _Pragma("unroll") for (int k = 0; k < 2; ++k) dst[n][k] = *(const PG8_LAS bf16x8*)(lds + PG8_SB(b, h) + boff + n * 2048 + k * 1024); } while (0)
#define PG8_MMA(ai, bj, At, Bt) do { __builtin_amdgcn_s_setprio(1); _Pragma("unroll") for (int m = 0; m < 4; ++m) _Pragma("unroll") for (int n = 0; n < 2; ++n) { \
        if constexpr (FP8) { const pg8_v8i a8_ = pg8_cat(Bt[n][0], Bt[n][1]), b8_ = pg8_cat(At[m][0], At[m][1]); asm volatile("v_mfma_f32_16x16x128_f8f6f4 %0, %1, %2, %0" : "+v"(acc[ai][bj][m][n]) : "v"(a8_), "v"(b8_)); } \
        else if constexpr (I8) { _Pragma("unroll") for (int k = 0; k < 2; ++k) acc[ai][bj][m][n] = __builtin_bit_cast(f32x4, __builtin_amdgcn_mfma_i32_16x16x64_i8(__builtin_bit_cast(pg8_v4i, Bt[n][k]), __builtin_bit_cast(pg8_v4i, At[m][k]), __builtin_bit_cast(pg8_v4i, acc[ai][bj][m][n]), 0, 0, 0)); } \
        else { _Pragma("unroll") for (int k = 0; k < 2; ++k) acc[ai][bj][m][n] = __builtin_amdgcn_mfma_f32_16x16x32_bf16(Bt[n][k], At[m][k], acc[ai][bj][m][n], 0, 0, 0); } } __builtin_amdgcn_s_setprio(0); } while (0)
#define PG8_WAIT_V(n) asm volatile("s_waitcnt vmcnt(" #n ")" ::: "memory")
#define PG8_WAIT_L(n) asm volatile("s_waitcnt lgkmcnt(" #n ")" ::: "memory")
#define PG8_BAR __builtin_amdgcn_s_barrier()
#define PG8_SCHED __builtin_amdgcn_sched_barrier(0)
    Unit cur, nxt; int ui = 0;
    if (!S.next(0, cur)) return;
    f32x4 acc[2][2][4][2];
#pragma unroll
    for (int a = 0; a < 2; ++a)
#pragma unroll
        for (int b = 0; b < 2; ++b)
#pragma unroll
            for (int m = 0; m < 4; ++m)
#pragma unroll
                for (int n = 0; n < 2; ++n) acc[a][b][m][n] = (f32x4){0.f, 0.f, 0.f, 0.f};
    bf16x8 At[4][2], B0[2][2], B1[2][2];
    const char* cA = (const char*)g.A + (size_t)cur.pm * tstep; const char* cB = (const char*)g.Bt + (size_t)cur.pn * tstep;
    S.a_ready(cur);
    if constexpr (SP2) {
        PG8_STAGEB(PG8_SB(0, 0), cB, voffB); PG8_STAGEB(PG8_SB(0, 1), cB + hstepB, voffB); PG8_STAGE(PG8_SA(0, 0), cA, voffA); PG8_STAGE(PG8_SA(0, 1), cA + hstepA, voffA);
        if (wr == 1) PG8_BAR;
        PG8_WAIT_V(2); PG8_BAR;
        PG8_STAGEB(PG8_SB(1, 0), cB + kstepB, voffB); PG8_STAGE(PG8_SA(1, 0), cA + kstepA, voffA); PG8_STAGEB(PG8_SB(1, 1), cB + hstepB + kstepB, voffB);
        PG8_WAIT_V(6); PG8_BAR;
    } else {
        PG8_STAGEB(PG8_SB(0, 0), cB, voffB); PG8_STAGE(PG8_SA(0, 0), cA, voffA); PG8_STAGEB(PG8_SB(0, 1), cB + hstepB, voffB); PG8_STAGE(PG8_SA(0, 1), cA + hstepA, voffA);
        if (wr == 1) PG8_BAR;
        PG8_WAIT_V(4); PG8_BAR;
        PG8_STAGEB(PG8_SB(1, 0), cB + kstepB, voffB); PG8_STAGE(PG8_SA(1, 0), cA + kstepA, voffA); PG8_STAGEB(PG8_SB(1, 1), cB + hstepB + kstepB, voffB);
        PG8_WAIT_V(6); PG8_BAR;
    }
    for (;;) {
        const bool has_next = S.next(ui + 1, nxt);
        const char* nA = has_next ? (const char*)g.A + (size_t)nxt.pm * tstep : cA; const char* nB = has_next ? (const char*)g.Bt + (size_t)nxt.pn * tstep : cB;
#define PG8_SETUP_T() \
            const bool last = (t == nt - 2); \
            const char* a1 = cA + PG8_KOFFA(t + 1);                                                    \
            const char* a2 = last ? nA : cA + PG8_KOFFA(t + 2); const char* b2 = last ? nB : cB + (size_t)(t + 2) * kstepB;     \
            const char* a3 = a2 + kstepA; const char* b3 = b2 + kstepB;                              \
            if (last && has_next) S.a_ready(nxt);
#define PG8_WAIT_VS(SLK) do { if (SLK) PG8_WAIT_V(24); else PG8_WAIT_V(8); } while (0)
#define PG8_ITER_SP2(SLK) \
              \
              \
            PG8_LDB(B0, 0, 0); PG8_LDB(B1, 0, 1); PG8_SCHED; PG8_LDA(At, 0, 0); if (!(SLK)) PG8_STAGE(PG8_SA(1, 1), a1 + hstepA, voffA); \
            PG8_WAIT_VS(SLK); PG8_WAIT_L(0); PG8_BAR; PG8_MMA(0, 0, At, B0); PG8_MMA(0, 1, At, B1); PG8_BAR; PG8_SCHED; \
              \
            PG8_LDA(At, 0, 1); PG8_STAGEB(PG8_SB(0, 0), b2, voffB); PG8_STAGEB(PG8_SB(0, 1), b2 + hstepB, voffB); PG8_STAGE(PG8_SA(0, 0), a2, voffA); \
            PG8_WAIT_VS(SLK); PG8_WAIT_L(0); PG8_BAR; PG8_MMA(1, 0, At, B0); PG8_MMA(1, 1, At, B1); PG8_BAR; PG8_SCHED; \
              \
            PG8_LDB(B0, 1, 0); PG8_LDB(B1, 1, 1); PG8_SCHED; PG8_LDA(At, 1, 0); PG8_STAGE(PG8_SA(0, 1), a2 + hstepA, voffA); \
            PG8_WAIT_VS(SLK); PG8_WAIT_L(0); PG8_BAR; PG8_MMA(0, 0, At, B0); PG8_MMA(0, 1, At, B1); PG8_BAR; PG8_SCHED; \
              \
            PG8_LDA(At, 1, 1); PG8_STAGEB(PG8_SB(1, 0), b3, voffB); PG8_STAGEB(PG8_SB(1, 1), b3 + hstepB, voffB); PG8_STAGE(PG8_SA(1, 0), a3, voffA); \
            PG8_WAIT_V(8); PG8_WAIT_L(0); PG8_BAR; PG8_MMA(1, 0, At, B0); PG8_MMA(1, 1, At, B1); PG8_BAR; PG8_SCHED;
        constexpr bool SLACK_OK = PG8_SLACK && SLK && SP2 && ALIGN_EPI && Epi::NST >= 16;
        int t = 0;
        if constexpr (SLACK_OK) { if (ui > 0) { PG8_SETUP_T() PG8_ITER_SP2(1) t = 2; } }
        for (; t < nt; t += 2) {
            PG8_SETUP_T()
            if constexpr (SP2) {
            PG8_ITER_SP2(0)
            } else {
            PG8_LDB(B0, 0, 0); PG8_SCHED; PG8_LDA(At, 0, 0); PG8_STAGE(PG8_SA(1, 1), a1 + hstepA, voffA);
            PG8_WAIT_L(8); PG8_BAR; PG8_WAIT_L(0); PG8_MMA(0, 0, At, B0); PG8_BAR; PG8_SCHED;
            PG8_LDB(B1, 0, 1); PG8_STAGEB(PG8_SB(0, 0), b2, voffB);
            PG8_BAR; PG8_WAIT_L(0); PG8_MMA(0, 1, At, B1); PG8_BAR;
            PG8_LDA(At, 0, 1); PG8_STAGE(PG8_SA(0, 0), a2, voffA);
            PG8_BAR; PG8_WAIT_L(0); PG8_MMA(1, 0, At, B0); PG8_BAR; PG8_SCHED;
            PG8_STAGEB(PG8_SB(0, 1), b2 + hstepB, voffB);
            PG8_WAIT_V(6); PG8_BAR; PG8_MMA(1, 1, At, B1); PG8_BAR;
            PG8_LDB(B0, 1, 0); PG8_SCHED; PG8_LDA(At, 1, 0); PG8_STAGE(PG8_SA(0, 1), a2 + hstepA, voffA);
            PG8_WAIT_L(8); PG8_BAR; PG8_WAIT_L(0); PG8_MMA(0, 0, At, B0); PG8_BAR; PG8_SCHED;
            PG8_LDB(B1, 1, 1); PG8_STAGEB(PG8_SB(1, 0), b3, voffB);
            PG8_BAR; PG8_WAIT_L(0); PG8_MMA(0, 1, At, B1); PG8_BAR;
            PG8_LDA(At, 1, 1); PG8_STAGE(PG8_SA(1, 0), a3, voffA);
            PG8_BAR; PG8_WAIT_L(0); PG8_MMA(1, 0, At, B0); PG8_BAR; PG8_SCHED;
            PG8_STAGEB(PG8_SB(1, 1), b3 + hstepB, voffB);
            PG8_WAIT_V(6); PG8_BAR; PG8_MMA(1, 1, At, B1); PG8_BAR;
            }
        }
        if constexpr (FP8) asm volatile("s_nop 15\n\ts_nop 15" ::: "memory");
        if constexpr (ALIGN_EPI) { if (wr == 0) PG8_BAR; }
        if constexpr (SLACK_OK) { if (has_next) PG8_STAGE(PG8_SA(1, 1), nA + PG8_KOFFA(1) + hstepA, voffA); }
        if constexpr (!Epi::AFTER_DRAIN) { int t2 = wave_tid(0); asm volatile("" : "+v"(t2)); E(acc, cur, wr, wc, t2 & 15, (t2 >> 4) & 3); S.done(cur); }
        if (!has_next) break;
#pragma unroll
        for (int a = 0; a < 2; ++a)
#pragma unroll
            for (int b = 0; b < 2; ++b)
#pragma unroll
                for (int m = 0; m < 4; ++m)
#pragma unroll
                    for (int n = 0; n < 2; ++n) acc[a][b][m][n] = (f32x4){0.f, 0.f, 0.f, 0.f};
        cur = nxt; cA = nA; cB = nB; ++ui;
        if constexpr (ALIGN_EPI) { if (wr == 1) PG8_BAR; }
    }
    PG8_WAIT_V(0);
    if constexpr (!ALIGN_EPI) { if (wr == 0) PG8_BAR; }
    PG8_BAR;
    if constexpr (Epi::AFTER_DRAIN) { E.fused(acc, cur, wr, wc, fr, fq, lds, wid, lane); S.done(cur); }
#undef PG8_KOFFA
#undef PG8_SETUP_T
#undef PG8_WAIT_VS
#undef PG8_ITER_SP2
#undef PG8_SA
#undef PG8_SB
#undef PG8_STAGE
#undef PG8_STAGEB
#undef PG8_LDA
#undef PG8_LDB
#undef PG8_MMA
#undef PG8_WAIT_V
#undef PG8_WAIT_L
#undef PG8_BAR
#undef PG8_SCHED
}
}
#ifndef PG8_SP2
#define PG8_SP2 true
#endif
#ifndef H_BLK
#define H_BLK 2
#endif
#ifndef Y_BLK
#define Y_BLK 1
#endif
#ifndef W_LIN
#define W_LIN true
#endif
#ifndef PG8_ALIGN
#define PG8_ALIGN true
#endif
constexpr int NWAVES = 8;
#ifndef MK_N_LAUNCHES
#define MK_N_LAUNCHES 1
#endif
#ifndef FP8_DOWN1
#define FP8_DOWN1 1
#endif
#ifndef I8_UP1
#define I8_UP1 1
#endif
#ifndef I8_UP0
#define I8_UP0 1
#endif
#ifndef I8_TEST
#define I8_TEST 0
#endif
#ifndef SKEW_UP
#define SKEW_UP 0
#endif
#ifndef SKEW_QKV
#define SKEW_QKV 0
#endif
#ifndef SKEW_O
#define SKEW_O 0
#endif
#ifndef SKEW_DN
#define SKEW_DN 0
#endif
#ifndef CMAX_SAFETY
#define CMAX_SAFETY 1.3f
#endif
#ifndef PROBE_EXPT
#define PROBE_EXPT 0
#endif
#ifndef PROBE_DUP
#define PROBE_DUP 0
#endif
constexpr int N_PHASES = 15;
constexpr int N_LAUNCHES = MK_N_LAUNCHES;

constexpr int BATCH = 4, SEQ = 4096, D = 2048, NH = 32, NKV = 4, HD = 64, FF = 8192;
constexpr int M = BATCH * SEQ;
constexpr int NQKV = 2560;
constexpr float RMS_EPS = 1e-6f;
constexpr float LOG2E = 1.4426950408889634f;
constexpr float QSCALE = 0.125f * LOG2E;

constexpr size_t MiB = 1u << 20;
constexpr size_t WS_CTL = 0, CTL_ZERO_BYTES = 1 * MiB;
constexpr size_t WS_W = 1 * MiB;
constexpr size_t W_QKV = 10 * MiB, W_O = 8 * MiB, W_UP = 32 * MiB, W_DN = 32 * MiB, W_LAYER = W_QKV + W_O + W_UP + W_DN;
constexpr size_t WS_H = WS_W + 2 * W_LAYER;
constexpr size_t WS_QO = WS_H;
constexpr size_t WS_XN = WS_H + 256 * MiB;
constexpr size_t WS_K = WS_XN + 64 * MiB;
constexpr size_t WS_VT = WS_K + 8 * MiB;
constexpr size_t WS_RS = WS_VT + 8 * MiB;
constexpr size_t WS_END = WS_RS + 1 * MiB;
constexpr int CW_BAR = 4096;
constexpr size_t XQ_OFF = 64 * MiB;
constexpr size_t CTL_CMAX = 768 * 1024;
constexpr size_t CTL_KMEAN = 512 * 1024;

constexpr int RING_OFF = 0, RING_BYTES = 131072;
constexpr int LDSCTL_OFF = RING_BYTES, MISC_OFF = LDSCTL_OFF + 320;
constexpr int LDS_BYTES = 151552;
constexpr int RSL_OFF = MISC_OFF + 256;
constexpr int CML_OFF = RSL_OFF + 8 * 1024;
static_assert(RSL_OFF % 16 == 0 && CML_OFF + 8 * 1024 <= LDS_BYTES, "LDS map");

#define GAS __attribute__((address_space(1)))
#define LAS __attribute__((address_space(3)))
typedef unsigned short bf16;
typedef unsigned v4u __attribute__((ext_vector_type(4)));
typedef unsigned v2u __attribute__((ext_vector_type(2)));
typedef float f32x4 __attribute__((ext_vector_type(4)));
typedef float f32x16 __attribute__((ext_vector_type(16)));
typedef short bf16x8 __attribute__((ext_vector_type(8)));
typedef GAS unsigned gu32;
#define RLX_AGENT __ATOMIC_RELAXED, __HIP_MEMORY_SCOPE_AGENT
#define LDS_WAIT() asm volatile("s_waitcnt lgkmcnt(0)" ::: "memory")
#define VM_WAIT() asm volatile("s_waitcnt vmcnt(0)" ::: "memory")
__device__ __forceinline__ unsigned f2bf(float f) { unsigned u = __builtin_bit_cast(unsigned, f); return (u + 0x7fffu + ((u >> 16) & 1u)) >> 16; }
__device__ __forceinline__ unsigned pk2(float lo, float hi) { return f2bf(lo) | (f2bf(hi) << 16); }
__device__ __forceinline__ unsigned cvtpk(float lo, float hi) { unsigned r; asm volatile("v_cvt_pk_bf16_f32 %0, %1, %2" : "=v"(r) : "v"(lo), "v"(hi)); return r; }
__device__ __forceinline__ float bflo(unsigned w) { return __builtin_bit_cast(float, w << 16); }
__device__ __forceinline__ float bfhi(unsigned w) { return __builtin_bit_cast(float, w & 0xffff0000u); }
#define XB_TMO      128
#define XB_XCNT(j)  (256  + 64 * (j))
#define XB_XSUB(j)  (1280 + 64 * (j))
#define XB_XGEN(j)  (2304 + 64 * (j))
#define XB_TOP      3328
#define XB_TOPGEN   3392
#define XCD_BAR_WORDS 3456
#define XB_SPIN_CAP (1u << 18)

__device__ __forceinline__ unsigned xb_ld(unsigned* p)              { return __hip_atomic_load(p, __ATOMIC_RELAXED, __HIP_MEMORY_SCOPE_AGENT); }
__device__ __forceinline__ unsigned xb_add(unsigned* p, unsigned v) { return __hip_atomic_fetch_add(p, v, __ATOMIC_RELAXED, __HIP_MEMORY_SCOPE_AGENT); }
__device__ __forceinline__ unsigned xb_xcc_id() { return (unsigned)__builtin_amdgcn_s_getreg((3 << 11) | 20) & 0xFu; }
#define XB_SPIN(cond, bar) do { unsigned _sp = 0; while (cond) { __builtin_amdgcn_s_sleep(1); \
    if ((++_sp & 255u) == 0u) { if (xb_ld(&(bar)[XB_TMO])) break; if (_sp > XB_SPIN_CAP) { atomicAdd(&(bar)[XB_TMO], 1u); break; } } } } while (0)

struct XcdBarrier {
    unsigned* bar; unsigned x; unsigned w;
    volatile LAS unsigned* st;
};

__device__ __forceinline__ XcdBarrier xcd_barrier_post(unsigned* bar, volatile LAS unsigned* st, unsigned w) {
    XcdBarrier b; b.bar = bar; b.x = xb_xcc_id(); b.st = st; b.w = w;
    if (b.w == 0u && pg8::lane_now() == 0) (void)xb_add(&bar[XB_XCNT(b.x)], 1u);
    return b;
}
__device__ __forceinline__ void xcd_barrier_complete(unsigned* bar, unsigned x, unsigned& nloc, unsigned& nx) {
    const unsigned G = gridDim.x * gridDim.y * gridDim.z;
    unsigned sum, cnt, mine, sp = 0u;
    for (;;) {
        sum = 0u; cnt = 0u; mine = 0u;
#pragma unroll
        for (unsigned j = 0; j < 16; ++j) { const unsigned c = xb_ld(&bar[XB_XCNT(j)]); sum += c; cnt += (c > 0u) ? 1u : 0u; mine = (j == x) ? c : mine; }
        if (sum == G) break;
        __builtin_amdgcn_s_sleep(1);
        if ((++sp & 255u) == 0u) { if (xb_ld(&bar[XB_TMO])) break; if (sp > XB_SPIN_CAP) { atomicAdd(&bar[XB_TMO], 1u); break; } }
    }
    nloc = mine > 0u ? mine : 1u; nx = cnt > 0u ? cnt : 1u;
}

__device__ __forceinline__ void xcd_barrier(const XcdBarrier& b) {
    asm volatile("s_waitcnt vmcnt(0)" ::: "memory");
    __syncthreads();
    if (b.w == 0u && pg8::lane_now() == 0) {
        unsigned* bar = b.bar;
        __builtin_amdgcn_s_waitcnt(0);
        unsigned nloc = b.st[0], nx = b.st[1];
        if (nloc == 0u) { xcd_barrier_complete(bar, b.x, nloc, nx); b.st[0] = nloc; b.st[1] = nx; }
        const unsigned old = xb_add(&bar[XB_XSUB(b.x)], 1u);
        const unsigned gen = old / nloc;
        if (old + 1u == (gen + 1u) * nloc) {
            __builtin_amdgcn_fence(__ATOMIC_RELEASE, "agent");
            asm volatile("s_waitcnt vmcnt(0)" ::: "memory");
            const unsigned og = xb_add(&bar[XB_TOP], 1u);
            const unsigned tg = og / nx;
            if (og + 1u == (tg + 1u) * nx) xb_add(&bar[XB_TOPGEN], 1u);
            else XB_SPIN(xb_ld(&bar[XB_TOPGEN]) == tg, bar);
            __builtin_amdgcn_fence(__ATOMIC_ACQUIRE, "agent");
            xb_add(&bar[XB_XGEN(b.x)], 1u);
            asm volatile("s_waitcnt vmcnt(0)" ::: "memory");
        } else {
            XB_SPIN(xb_ld(&bar[XB_XGEN(b.x)]) == gen, bar);
            __builtin_amdgcn_fence(__ATOMIC_ACQUIRE, "agent");
            asm volatile("s_waitcnt vmcnt(0)" ::: "memory");
        }
    }
    __syncthreads();
}
struct Frame {
    LAS unsigned char* lds;
    volatile LAS unsigned* MISC;
    gu32* ctl;
    int tid, lane, wave;
    int vcu, G;
};
__device__ __forceinline__ float wave_sum(float v) {
#pragma unroll
    for (int o = 1; o < 64; o <<= 1) v += __shfl_xor(v, o);
    return v;
}
__device__ __forceinline__ size_t wlin_off(int n, int kbyte, int KB) {
    const int nl = n & 255, n7 = nl & 127, c32 = n7 & 31;
    const int rho = (n7 & ~31) + ((c32 >> 2) & 1) * 16 + ((c32 >> 3) << 2) + (c32 & 3);
    return (size_t)(n >> 8) * 256 * KB + (size_t)(kbyte >> 7) * 32768 + (nl >> 7) * 16384 + pg8::lds_byte(rho, (kbyte & 127) >> 1) + (kbyte & 1);
}
struct CvItem { const float* W; const float* g; bf16* WT; int K, N, row_off, r; float f8; unsigned* cmax; int q8;         };
__device__ __forceinline__ void cv_load(const CvItem& c, f32x4 (&v)[8], int lane) {
    const int nblk = c.N / 32, kb = c.r / nblk, nb = c.r % nblk, k0 = 64 * kb, n0 = 32 * nb; const int kq = lane >> 3, n4 = (lane & 7) * 4;
#pragma unroll
    for (int i = 0; i < 8; ++i) v[i] = *(const GAS f32x4*)(c.W + (size_t)(k0 + 8 * i + kq) * c.N + n0 + n4);
}
__device__ __forceinline__ void cv_finish(const CvItem& c, const f32x4 (&v)[8], LAS float* scr, int lane) {
    const int nblk = c.N / 32, kb = c.r / nblk, nb = c.r % nblk, k0 = 64 * kb, n0 = 32 * nb; const int kq = lane >> 3, n4 = (lane & 7) * 4;
#pragma unroll
    for (int i = 0; i < 8; ++i) { LAS float* d = scr + (8 * i + kq) * 33 + n4; d[0] = v[i].x; d[1] = v[i].y; d[2] = v[i].z; d[3] = v[i].w; }
    const int cc = lane & 7;
    f32x4 g0 = (f32x4){1.f, 1.f, 1.f, 1.f}, g1 = g0;
    if (c.g) { g0 = *(const f32x4*)(c.g + k0 + 8 * cc); g1 = *(const f32x4*)(c.g + k0 + 8 * cc + 4); }
    LDS_WAIT(); asm volatile("" ::: "memory");
#pragma unroll
    for (int j = 0; j < 4; ++j) { const int n = (lane >> 3) + 8 * j; const LAS float* s = scr + (8 * cc) * 33 + n;
        float gg[8]; gg[0] = g0[0]; gg[1] = g0[1]; gg[2] = g0[2]; gg[3] = g0[3]; gg[4] = g1[0]; gg[5] = g1[1]; gg[6] = g1[2]; gg[7] = g1[3];
        if (c.cmax && !c.q8) { float mx = 0.f;
#pragma unroll
            for (int e = 0; e < 8; ++e) mx = fmaxf(mx, fabsf(s[e * 33] * gg[e]));
            mx = fmaxf(mx, __shfl_xor(mx, 1)); mx = fmaxf(mx, __shfl_xor(mx, 2)); mx = fmaxf(mx, __shfl_xor(mx, 4));
            if (cc == 0) __hip_atomic_fetch_max(c.cmax + n0 + n, __builtin_bit_cast(unsigned, mx * CMAX_SAFETY), __ATOMIC_RELAXED, __HIP_MEMORY_SCOPE_AGENT);
            continue; }
        if (c.cmax && c.q8) { const float qs = 127.0f / fmaxf(__builtin_bit_cast(float, c.cmax[n0 + n]), 1e-30f); int q[8];
#pragma unroll
            for (int e = 0; e < 8; ++e) q[e] = (int)rintf(fminf(fmaxf(s[e * 33] * gg[e] * qs, -127.0f), 127.0f));
            if (I8_TEST == 1 || I8_TEST == 3) { const float dq = 1.0f / qs; v4u o; o.x = pk2(q[0] * dq, q[1] * dq); o.y = pk2(q[2] * dq, q[3] * dq); o.z = pk2(q[4] * dq, q[5] * dq); o.w = pk2(q[6] * dq, q[7] * dq);
                *(GAS v4u*)((unsigned char*)c.WT + wlin_off(c.row_off + n0 + n, (k0 + 8 * cc) * 2, c.K * 2)) = o; continue; }
            v2u o8; o8.x = (unsigned)(q[0] & 255) | ((unsigned)(q[1] & 255) << 8) | ((unsigned)(q[2] & 255) << 16) | ((unsigned)(q[3] & 255) << 24);
            o8.y = (unsigned)(q[4] & 255) | ((unsigned)(q[5] & 255) << 8) | ((unsigned)(q[6] & 255) << 16) | ((unsigned)(q[7] & 255) << 24);
            *(GAS v2u*)((unsigned char*)c.WT + wlin_off(c.row_off + n0 + n, k0 + 8 * cc, c.K)) = o8; continue; }
        if (c.f8 != 0.f) { const float f = c.f8; v2u o8; o8.x = pg8::pk_fp8x4(s[0 * 33] * f, s[1 * 33] * f, s[2 * 33] * f, s[3 * 33] * f); o8.y = pg8::pk_fp8x4(s[4 * 33] * f, s[5 * 33] * f, s[6 * 33] * f, s[7 * 33] * f);
            *(GAS v2u*)((unsigned char*)c.WT + wlin_off(c.row_off + n0 + n, k0 + 8 * cc, c.K)) = o8; continue; }
        v4u o; o.x = pk2(s[0 * 33] * g0[0], s[1 * 33] * g0[1]); o.y = pk2(s[2 * 33] * g0[2], s[3 * 33] * g0[3]); o.z = pk2(s[4 * 33] * g1[0], s[5 * 33] * g1[1]); o.w = pk2(s[6 * 33] * g1[2], s[7 * 33] * g1[3]);
        *(GAS v4u*)((unsigned char*)c.WT + wlin_off(c.row_off + n0 + n, (k0 + 8 * cc) * 2, c.K * 2)) = o; }
    LDS_WAIT(); asm volatile("" ::: "memory");
}
__device__ __forceinline__ void rms_row_to_bf16(const float* xrow, bf16* orow, float* rsp, int lane) {
    f32x4 v[4][2]; float s = 0.f;
#pragma unroll
    for (int j = 0; j < 4; ++j)
#pragma unroll
        for (int e = 0; e < 2; ++e) { v[j][e] = *(const GAS f32x4*)(xrow + j * 512 + 8 * lane + 4 * e); s += (v[j][e].x * v[j][e].x + v[j][e].y * v[j][e].y) + (v[j][e].z * v[j][e].z + v[j][e].w * v[j][e].w); }
    const float rs = 1.0f / sqrtf(wave_sum(s) * (1.f / D) + RMS_EPS);
    if (lane == 0) *rsp = rs;
#pragma unroll
    for (int j = 0; j < 4; ++j) { v4u o; o.x = pk2(v[j][0].x, v[j][0].y); o.y = pk2(v[j][0].z, v[j][0].w); o.z = pk2(v[j][1].x, v[j][1].y); o.w = pk2(v[j][1].z, v[j][1].w);
        *(GAS v4u*)(orow + j * 512 + 8 * lane) = o; }
}
template <bool LAST>
__device__ __forceinline__ void thin_phase(Frame& F, const bf16* Y, const float* XF, bf16* XR, float* RS, float* OUT, const float* gpost, signed char* XQ = nullptr) {
    const int gw = F.vcu * NWAVES + F.wave, NGW = F.G * NWAVES, lane = pg8::lane_now();
    f32x4 g[4][2];
#pragma unroll
    for (int j = 0; j < 4; ++j)
#pragma unroll
        for (int e = 0; e < 2; ++e) g[j][e] = *(const GAS f32x4*)(gpost + j * 512 + 8 * lane + 4 * e);
    for (int m = gw; m < M; m += NGW) {
        const bf16* yr = Y + (size_t)m * D; bf16* xrr = XR + (size_t)m * D;
        v4u yv[4]; f32x4 xv[4][2];
#pragma unroll
        for (int j = 0; j < 4; ++j) yv[j] = Y_BLK ? *(const GAS v4u*)(Y + ((size_t)((m >> 8) * 8 + 2 * j + (lane >> 5)) * 256 + (m & 255)) * 256 + 8 * (lane & 31))
                                             : *(const GAS v4u*)(yr + j * 512 + 8 * lane);
        if (XF) {
            const float* xr = XF + (size_t)m * D;
#pragma unroll
            for (int j = 0; j < 4; ++j) { xv[j][0] = *(const GAS f32x4*)(xr + j * 512 + 8 * lane); xv[j][1] = *(const GAS f32x4*)(xr + j * 512 + 8 * lane + 4); }
        } else {
#pragma unroll
            for (int j = 0; j < 4; ++j) { const v4u w = *(const GAS v4u*)(xrr + j * 512 + 8 * lane);
                xv[j][0] = (f32x4){bflo(w.x), bfhi(w.x), bflo(w.y), bfhi(w.y)}; xv[j][1] = (f32x4){bflo(w.z), bfhi(w.z), bflo(w.w), bfhi(w.w)}; }
        }
        f32x4 yf[4][2]; float s = 0.f;
#pragma unroll
        for (int j = 0; j < 4; ++j) { yf[j][0] = (f32x4){bflo(yv[j].x), bfhi(yv[j].x), bflo(yv[j].y), bfhi(yv[j].y)}; yf[j][1] = (f32x4){bflo(yv[j].z), bfhi(yv[j].z), bflo(yv[j].w), bfhi(yv[j].w)};
#pragma unroll
            for (int e = 0; e < 2; ++e) s += (yf[j][e].x * yf[j][e].x + yf[j][e].y * yf[j][e].y) + (yf[j][e].z * yf[j][e].z + yf[j][e].w * yf[j][e].w); }
        const float rs = 1.0f / sqrtf(wave_sum(s) * (1.f / D) + RMS_EPS);
        float s2 = 0.f;
#pragma unroll
        for (int j = 0; j < 4; ++j)
#pragma unroll
            for (int e = 0; e < 2; ++e) { xv[j][e] = xv[j][e] + (yf[j][e] * rs) * g[j][e]; s2 += (xv[j][e].x * xv[j][e].x + xv[j][e].y * xv[j][e].y) + (xv[j][e].z * xv[j][e].z + xv[j][e].w * xv[j][e].w); }
        if (LAST) {
            float* xo = OUT + (size_t)m * D;
#pragma unroll
            for (int j = 0; j < 4; ++j) { *(GAS f32x4*)(xo + j * 512 + 8 * lane) = xv[j][0]; *(GAS f32x4*)(xo + j * 512 + 8 * lane + 4) = xv[j][1]; }
        } else {
            const float rs2 = 1.0f / sqrtf(wave_sum(s2) * (1.f / D) + RMS_EPS);
            if (XQ) {
                float am = 0.f;
#pragma unroll
                for (int j = 0; j < 4; ++j)
#pragma unroll
                    for (int e = 0; e < 2; ++e) am = fmaxf(fmaxf(am, fmaxf(fabsf(xv[j][e].x), fabsf(xv[j][e].y))), fmaxf(fabsf(xv[j][e].z), fabsf(xv[j][e].w)));
#pragma unroll
                for (int o = 1; o < 64; o <<= 1) am = fmaxf(am, __shfl_xor(am, o));
                am = fmaxf(am, 1e-30f);
                const float qs = 127.0f / am;
                if (I8_TEST == 2 || I8_TEST == 3) {
                    if (lane == 0) RS[m] = rs2;
#pragma unroll
                    for (int j = 0; j < 4; ++j)
#pragma unroll
                        for (int e = 0; e < 2; ++e) { xv[j][e].x = rintf(xv[j][e].x * qs) / qs; xv[j][e].y = rintf(xv[j][e].y * qs) / qs; xv[j][e].z = rintf(xv[j][e].z * qs) / qs; xv[j][e].w = rintf(xv[j][e].w * qs) / qs; }
                } else {
                if (lane == 0) RS[m] = rs2 * am * (1.0f / 127.0f);
                signed char* xq = XQ + (size_t)m * D;
#pragma unroll
                for (int j = 0; j < 4; ++j) { int q[8];
#pragma unroll
                    for (int e = 0; e < 2; ++e) { q[4 * e + 0] = (int)rintf(xv[j][e].x * qs); q[4 * e + 1] = (int)rintf(xv[j][e].y * qs); q[4 * e + 2] = (int)rintf(xv[j][e].z * qs); q[4 * e + 3] = (int)rintf(xv[j][e].w * qs); }
                    v2u w; w.x = (unsigned)(q[0] & 255) | ((unsigned)(q[1] & 255) << 8) | ((unsigned)(q[2] & 255) << 16) | ((unsigned)(q[3] & 255) << 24);
                    w.y = (unsigned)(q[4] & 255) | ((unsigned)(q[5] & 255) << 8) | ((unsigned)(q[6] & 255) << 16) | ((unsigned)(q[7] & 255) << 24);
                    *(GAS v2u*)(xq + j * 512 + 8 * lane) = w; }
                }
            } else
            if (lane == 0) RS[m] = rs2;
#pragma unroll
            for (int j = 0; j < 4; ++j) { v4u o; o.x = pk2(xv[j][0].x, xv[j][0].y); o.y = pk2(xv[j][0].z, xv[j][0].w); o.z = pk2(xv[j][1].x, xv[j][1].y); o.w = pk2(xv[j][1].z, xv[j][1].w);
                *(GAS v4u*)(xrr + j * 512 + 8 * lane) = o; }
        }
    }
}
#ifndef ATTN_STEADY
#define ATTN_STEADY 1
#endif
#ifndef AT_VTR
#define AT_VTR 1
#endif
#ifndef AT_PRIO
#define AT_PRIO 0
#endif
#ifndef AT_MSUM
#define AT_MSUM 0
#endif
#ifndef AT_EARLY_PREFETCH
#define AT_EARLY_PREFETCH 1
#endif
constexpr int AT_SKEW = 4;
constexpr int AT_ROWB = 144;
constexpr int AT_VROWB = AT_VTR ? 192 : AT_ROWB;
constexpr int AT_TILEB = 64 * AT_ROWB, AT_VTILEB = 64 * AT_VROWB, AT_BUFB = AT_TILEB + AT_VTILEB, AT_STAGEB = 2 * AT_BUFB;
typedef short at_s16x4 __attribute__((ext_vector_type(4)));
__device__ __forceinline__ bf16x8 at_vtr(const LAS unsigned char* p) {
    const at_s16x4 a = __builtin_amdgcn_ds_read_tr16_b64_v4i16((LAS at_s16x4*)(p)), b = __builtin_amdgcn_ds_read_tr16_b64_v4i16((LAS at_s16x4*)(p + 4 * AT_VROWB));
    return (bf16x8){a[0], a[1], a[2], a[3], b[0], b[1], b[2], b[3]}; }
constexpr int AT_KM_OFF = 2 * AT_STAGEB + 256, AT_KM_ROWB = 272;
typedef float at_v2f __attribute__((ext_vector_type(2)));
#define ST_SB() __builtin_amdgcn_sched_barrier(0)
#define ST_MF(A_, B_, C_) ((EXPT == 3) ? (C_) : __builtin_amdgcn_mfma_f32_32x32x16_bf16(A_, B_, C_, 0, 0, 0))
#define ST_EX(X_) ((EXPT == 4) ? (X_) : __builtin_amdgcn_exp2f(X_))
#define ST_PIN(X) asm volatile("" : "+v"(X))
#define ST_KRD(BUF, HF, K0, K1, K2, K3) do { const LAS unsigned char* kb_ = (BUF) + kfo + (HF) * 32 * AT_ROWB; \
    K0 = *(const LAS bf16x8*)(kb_); K1 = *(const LAS bf16x8*)(kb_ + 32); K2 = *(const LAS bf16x8*)(kb_ + 64); K3 = *(const LAS bf16x8*)(kb_ + 96); } while (0)
#define ST_CINIT(A, T0G, JT, HF, P) do { const int s0_ = (JT) * 64 + 32 * (HF); const int j_ = (JT) >> 2; const bool sel_ = (MODE == 0) || (j_ == qb) || ((A.sel >> j_) & 1u); \
    const float base_ = sel_ ? slope2 * (float)(s0_ + 8 * hi - (T0G) - r32) - A.mref : -INFINITY; \
    _Pragma("unroll") for (int r = 0; r < 16; ++r) { const float c = (float)(16 * (r >> 3) + (r & 7)); P[r] = __builtin_fmaf(slope2, c, base_); } } while (0)
#define ST_EXP4(P, J) do { P[4 * (J)] = ST_EX(P[4 * (J)]); P[4 * (J) + 1] = ST_EX(P[4 * (J) + 1]); P[4 * (J) + 2] = ST_EX(P[4 * (J) + 2]); P[4 * (J) + 3] = ST_EX(P[4 * (J) + 3]); } while (0)
#define ST_MAXA(P, MA) do { MA = __builtin_fmaxf(__builtin_fmaxf(P[0], P[1]), P[2]); MA = __builtin_fmaxf(__builtin_fmaxf(MA, P[3]), P[4]); MA = __builtin_fmaxf(__builtin_fmaxf(MA, P[5]), P[6]); MA = __builtin_fmaxf(MA, P[7]); } while (0)
#define ST_MAXB(P, MA, MT) do { float mb_ = __builtin_fmaxf(__builtin_fmaxf(P[8], P[9]), P[10]); mb_ = __builtin_fmaxf(__builtin_fmaxf(mb_, P[11]), P[12]); mb_ = __builtin_fmaxf(__builtin_fmaxf(mb_, P[13]), P[14]); MT = __builtin_fmaxf(__builtin_fmaxf(mb_, P[15]), MA); } while (0)
#define ST_SUMCVT(A, P, PW0, PW1) do { if (!AT_MSUM) { float ls_ = ((P[0] + P[1]) + (P[2] + P[3])) + ((P[4] + P[5]) + (P[6] + P[7])); ls_ += ((P[8] + P[9]) + (P[10] + P[11])) + ((P[12] + P[13]) + (P[14] + P[15])); A.lrow += ls_; } \
    PW0.x = cvtpk(P[0], P[1]); PW0.y = cvtpk(P[2], P[3]); PW0.z = cvtpk(P[4], P[5]); PW0.w = cvtpk(P[6], P[7]); PW1.x = cvtpk(P[8], P[9]); PW1.y = cvtpk(P[10], P[11]); PW1.z = cvtpk(P[12], P[13]); PW1.w = cvtpk(P[14], P[15]); } while (0)
#define ST_VRD(BUF, HF, VA0, VB0, VA1, VB1) do { VA0 = ST_V(BUF, HF, 0, 0); VB0 = ST_V(BUF, HF, 0, 1); VA1 = ST_V(BUF, HF, 1, 0); VB1 = ST_V(BUF, HF, 1, 1); } while (0)
#define ST_CHK(A, P, MT) do { if (EXPT != 5 && __any(MT > 8.0f)) { const float m2 = __builtin_fmaxf(MT, __shfl_xor(MT, 32)); const float dl = (m2 > 8.0f) ? m2 : 0.f; A.mref += dl; const float alpha = __builtin_amdgcn_exp2f(-dl); A.lrow *= alpha; \
    if (AT_MSUM) { if (A.gi == 0) osum[0] *= alpha; else osum[8] *= alpha; } _Pragma("unroll") for (int r = 0; r < 16; ++r) { A.o0[r] *= alpha; A.o1[r] *= alpha; P[r] -= dl; } } } while (0)
#define ST_HEAD(An, T0n, JTn, HFn, BUFn, Pn, MTn) do { bf16x8 k0_, k1_, k2_, k3_; ST_KRD(BUFn, HFn, k0_, k1_, k2_, k3_); ST_CINIT(An, T0n, JTn, HFn, Pn); \
    Pn = __builtin_amdgcn_mfma_f32_32x32x16_bf16(k0_, An.qr[0], Pn, 0, 0, 0); Pn = __builtin_amdgcn_mfma_f32_32x32x16_bf16(k1_, An.qr[1], Pn, 0, 0, 0); \
    Pn = __builtin_amdgcn_mfma_f32_32x32x16_bf16(k2_, An.qr[2], Pn, 0, 0, 0); Pn = __builtin_amdgcn_mfma_f32_32x32x16_bf16(k3_, An.qr[3], Pn, 0, 0, 0); \
    if (need_chk) { float ma_; ST_MAXA(Pn, ma_); ST_MAXB(Pn, ma_, MTn); ST_CHK(An, Pn, MTn); } } while (0)
#define ST_K(BUF, HF, D0) (*(const LAS bf16x8*)((BUF) + kfo + (HF) * 32 * AT_ROWB + 32 * (D0)))
#define ST_V(BUF, HF, SP, DB) (AT_VTR ? at_vtr((BUF) + vfo + (32 * (HF) + 16 * (SP)) * AT_VROWB + (DB) * 64) : *(const LAS bf16x8*)((BUF) + vfo + (HF) * 64 + 32 * (SP) + (DB) * 32 * AT_ROWB))
#define ST_JOIN(An, T0n, JTn, HFn, BUFn, Pn, MTn, Ac, HFc, BUFc, Pc) do { \
    const bf16x8 k0_ = ST_K(BUFn, HFn, 0), k1_ = ST_K(BUFn, HFn, 1), k2_ = ST_K(BUFn, HFn, 2), k3_ = ST_K(BUFn, HFn, 3); ST_CINIT(An, T0n, JTn, HFn, Pn); ST_EXP4(Pc, 0); ST_EXP4(Pc, 1); ST_PIN(Pc); ST_SB(); \
    Pn = ST_MF(k0_, An.qr[0], Pn); bf16x8 va_ = ST_V(BUFc, HFc, 0, 0), vb_ = ST_V(BUFc, HFc, 0, 1); ST_EXP4(Pc, 2); ST_PIN(Pc); ST_SB(); \
    Pn = ST_MF(k1_, An.qr[1], Pn); ST_EXP4(Pc, 3); ST_PIN(Pc); ST_SB(); \
    v4u pw0_, pw1_; \
    Pn = ST_MF(k2_, An.qr[2], Pn); ST_SUMCVT(Ac, Pc, pw0_, pw1_); ST_SB(); \
    Pn = ST_MF(k3_, An.qr[3], Pn); ST_SB(); \
    float ma_; \
    Ac.o0 = ST_MF(va_, __builtin_bit_cast(bf16x8, pw0_), Ac.o0); Ac.o1 = ST_MF(vb_, __builtin_bit_cast(bf16x8, pw0_), Ac.o1); \
    va_ = ST_V(BUFc, HFc, 1, 0); vb_ = ST_V(BUFc, HFc, 1, 1); ST_SB(); \
    Ac.o0 = ST_MF(va_, __builtin_bit_cast(bf16x8, pw1_), Ac.o0); Ac.o1 = ST_MF(vb_, __builtin_bit_cast(bf16x8, pw1_), Ac.o1); \
    if (AT_MSUM) { osum = ST_MF(Ac.of, __builtin_bit_cast(bf16x8, pw0_), osum); osum = ST_MF(Ac.of, __builtin_bit_cast(bf16x8, pw1_), osum); } ST_SB(); \
    if (need_chk) { ST_MAXA(Pn, ma_); ST_MAXB(Pn, ma_, MTn); ST_CHK(An, Pn, MTn); } } while (0)
#define ST_TAIL(Ac, HFc, BUFc, Pc) do { ST_EXP4(Pc, 0); ST_EXP4(Pc, 1); ST_EXP4(Pc, 2); ST_EXP4(Pc, 3); bf16x8 va0_, vb0_, va1_, vb1_; ST_VRD(BUFc, HFc, va0_, vb0_, va1_, vb1_); v4u pw0_, pw1_; ST_SUMCVT(Ac, Pc, pw0_, pw1_); \
    Ac.o0 = __builtin_amdgcn_mfma_f32_32x32x16_bf16(va0_, __builtin_bit_cast(bf16x8, pw0_), Ac.o0, 0, 0, 0); Ac.o1 = __builtin_amdgcn_mfma_f32_32x32x16_bf16(vb0_, __builtin_bit_cast(bf16x8, pw0_), Ac.o1, 0, 0, 0); \
    Ac.o0 = __builtin_amdgcn_mfma_f32_32x32x16_bf16(va1_, __builtin_bit_cast(bf16x8, pw1_), Ac.o0, 0, 0, 0); Ac.o1 = __builtin_amdgcn_mfma_f32_32x32x16_bf16(vb1_, __builtin_bit_cast(bf16x8, pw1_), Ac.o1, 0, 0, 0); \
    if (AT_MSUM) { osum = __builtin_amdgcn_mfma_f32_32x32x16_bf16(Ac.of, __builtin_bit_cast(bf16x8, pw0_), osum, 0, 0, 0); osum = __builtin_amdgcn_mfma_f32_32x32x16_bf16(Ac.of, __builtin_bit_cast(bf16x8, pw1_), osum, 0, 0, 0); } } while (0)
struct AttnGrp { bf16x8 qr[4]; f32x16 o0, o1; bf16x8 of; float mref, lrow, cs; unsigned sel; int gi; };
#define AT_UNIT_DESC(U, B_, KVH_, TG_) const int B_ = vcu >> 6, KVH_ = (U); const int TG_ = ((U) & 1) ? 63 - (vcu & 63) : (vcu & 63);
template <int MODE, int EXPT = 0>
__device__ __forceinline__ void attn_units(int wave, int vcu, const bf16* QO, bf16* OB, const bf16* Kb, const bf16* Vt, const float* kmean, const float* kmaxp, const float* sinks, LAS unsigned char* lds) {
    int tid_ = pg8::wave_tid(wave); asm volatile("" : "+v"(tid_));
    const int wid = wave;
    const int sdst = (tid_ >> 3) * AT_ROWB + (tid_ & 7) * 16;
    const int r32o = tid_ & 31, hio = (tid_ >> 5) & 1;
    const int i16 = r32o & 15, krow = (r32o & 16) + ((i16 & 3) | (((i16 >> 3) & 1) << 2) | (((i16 >> 2) & 1) << 3));
    const int kfo = krow * AT_ROWB + hio * 16;
    const int vfo = AT_VTR ? AT_TILEB + (8 * hio + ((r32o & 15) >> 2)) * AT_VROWB + 32 * ((r32o >> 4) & 1) + 8 * (r32o & 3)
                           : AT_TILEB + r32o * AT_ROWB + hio * 16;
    const int sdstv = AT_VTR ? (tid_ >> 3) * AT_VROWB + (tid_ & 7) * 16 : sdst;
    AttnGrp G[2];
    f32x16 osum;
    v4u kst0, vst0, kst1, vst1; at_v2f kmst = {0.f, 0.f};
    bf16x8 qn[2][4];
#define AT_UNIT_LOADS(B_, KVH_, TG_) do { \
        int r32_ = r32, srow_ = srow; asm volatile("" : "+v"(r32_), "+v"(srow_));     \
        const int h_ = (KVH_) * 8 + wid, t0_ = (TG_) * 64; const size_t rb_ = (size_t)(B_) * SEQ; \
        _Pragma("unroll") for (int g = 0; g < 2; ++g) { const size_t qrow_ = rb_ + t0_ + 32 * g + r32_; \
            const bf16* Qw = QO_BLK ? QO + ((size_t)((qrow_ >> 8) * 8 + (h_ >> 2)) * 256 + (qrow_ & 255)) * 256 + (h_ & 3) * 64 + hi * 8 : QO + qrow_ * D + h_ * HD + hi * 8;     \
            _Pragma("unroll") for (int d0 = 0; d0 < 4; ++d0) qn[g][d0] = *(const GAS bf16x8*)(Qw + d0 * 16); } \
        const int jl_ = (MODE == 0) ? ((t0_ >= 128 ? t0_ - 127 : 0) >> 6) : 0, jh_ = (TG_); \
        const bf16* kg_ = Kb + (rb_ + srow_) * 256 + (KVH_) * 64 + sch * 8; const bf16* vg_ = AT_VTR ? Vt + (rb_ + srow_) * 256 + (KVH_) * 64 + sch * 8 : Vt + ((size_t)(((B_) * 4 + (KVH_)) * 64 + srow_)) * SEQ + sch * 8; \
        kst0 = *(const GAS v4u*)(kg_ + (size_t)(jh_ * 64) * 256); vst0 = *(const GAS v4u*)(vg_ + (size_t)(jh_ * 64) * (AT_VTR ? 256 : 1)); \
        if (jh_ > jl_) { kst1 = *(const GAS v4u*)(kg_ + (size_t)((jh_ - 1) * 64) * 256); vst1 = *(const GAS v4u*)(vg_ + (size_t)((jh_ - 1) * 64) * (AT_VTR ? 256 : 1)); } \
        if (MODE == 1) kmst = *(const GAS at_v2f*)(kmean + ((size_t)((B_) * 16 + (srow_ >> 2))) * 256 + (KVH_) * 64 + ((((srow_ & 3) << 3) + sch) << 1)); } while (0)
    { const int r32 = tid_ & 31, hi = (tid_ >> 5) & 1, srow = tid_ >> 3, sch = tid_ & 7; AT_UNIT_DESC(0, b0_, k0_, g0_) AT_UNIT_LOADS(b0_, k0_, g0_); }
    float kbd0, kbd1, kbd2, kbd3;
    { const float* kp = kmaxp + (vcu >> 6) * 8; kbd0 = sqrtf(kp[0] + kp[1]) * 1.02f; kbd1 = sqrtf(kp[2] + kp[3]) * 1.02f; kbd2 = sqrtf(kp[4] + kp[5]) * 1.02f; kbd3 = sqrtf(kp[6] + kp[7]) * 1.02f;
      kbd0 = __builtin_bit_cast(float, __builtin_amdgcn_readfirstlane(__builtin_bit_cast(int, kbd0))); kbd1 = __builtin_bit_cast(float, __builtin_amdgcn_readfirstlane(__builtin_bit_cast(int, kbd1)));
      kbd2 = __builtin_bit_cast(float, __builtin_amdgcn_readfirstlane(__builtin_bit_cast(int, kbd2))); kbd3 = __builtin_bit_cast(float, __builtin_amdgcn_readfirstlane(__builtin_bit_cast(int, kbd3))); }
    for (int un = 0; un < 4; ++un) {
    int tidl_ = tid_; asm volatile("" : "+v"(tidl_));
    const int tid = tidl_, lane = tid & 63, r32 = lane & 31, hi = lane >> 5, srow = tid >> 3, sch = tid & 7;
    AT_UNIT_DESC(un, b, kvh, tg)
    const int h = kvh * 8 + wid, t0 = tg * 64; const size_t rowbase = (size_t)b * SEQ;
    const float slope2 = __builtin_amdgcn_exp2f(-0.25f * (float)(h + 1)) * LOG2E;
#pragma unroll
    for (int g = 0; g < 2; ++g)
#pragma unroll
      for (int d0 = 0; d0 < 4; ++d0) G[g].qr[d0] = qn[g][d0];
    G[0].gi = 0; G[1].gi = 1;
    if (MODE == 1 && AT_MSUM) { const unsigned o0_ = (r32 < 16) ? 0x3f803f80u : 0u, o1_ = (r32 < 16) ? 0u : 0x3f803f80u;
        G[0].of = __builtin_bit_cast(bf16x8, (v4u){o0_, o0_, o0_, o0_}); G[1].of = __builtin_bit_cast(bf16x8, (v4u){o1_, o1_, o1_, o1_}); }
    int jt_lo = (MODE == 0) ? ((t0 >= 128 ? t0 - 127 : 0) >> 6) : 0; const int jt_hi = tg;
    const bf16* kg = Kb + (rowbase + srow) * 256 + kvh * 64 + sch * 8;
    const bf16* vg = AT_VTR ? Vt + (rowbase + srow) * 256 + kvh * 64 + sch * 8 : Vt + ((size_t)((b * 4 + kvh) * 64 + srow)) * SEQ + sch * 8;
    const int qb = t0 >> 8;
    const float kbound = (kvh == 0) ? kbd0 : (kvh == 1) ? kbd1 : (kvh == 2) ? kbd2 : kbd3;
#pragma unroll
    for (int g = 0; g < 2; ++g) {
        float q2 = 0.f;
#pragma unroll
        for (int d0 = 0; d0 < 4; ++d0)
#pragma unroll
            for (int e = 0; e < 1; ++e) { const v4u qw = __builtin_bit_cast(v4u, G[g].qr[d0]); const f32x4 ql = __builtin_bit_cast(f32x4, qw << 16), qh = __builtin_bit_cast(f32x4, qw & 0xffff0000u);
                q2 += (ql.x * ql.x + ql.y * ql.y) + (ql.z * ql.z + ql.w * ql.w) + (qh.x * qh.x + qh.y * qh.y) + (qh.z * qh.z + qh.w * qh.w); }
        q2 += __shfl_xor(q2, 32);
        G[g].cs = sqrtf(q2) * kbound;
        G[g].mref = 0.f; G[g].lrow = 0.f;
    }
    const bool need_chk = !__all(fmaxf(G[0].cs, G[1].cs) < 40.0f);
    float smin_w = -1e30f;
    *(LAS v4u*)(lds + sdst) = kst0; *(LAS v4u*)(lds + AT_TILEB + sdstv) = vst0;
    if (jt_hi > jt_lo) { *(LAS v4u*)(lds + AT_BUFB + sdst) = kst1; *(LAS v4u*)(lds + AT_BUFB + AT_TILEB + sdstv) = vst1; }
    if (MODE == 1) *(LAS at_v2f*)(lds + AT_KM_OFF + (tid >> 5) * AT_KM_ROWB + (tid & 31) * 8) = kmst;
    __syncthreads();
    G[0].sel = 0u; G[1].sel = 0u;
    if (MODE == 1 && EXPT != 9) {
        const LAS unsigned char* kml = lds + AT_KM_OFF + (r32 < 16 ? r32 : 15) * AT_KM_ROWB + hi * 32;
        f32x4 kk[4][2];
#pragma unroll
        for (int d0 = 0; d0 < 4; ++d0) { kk[d0][0] = *(const LAS f32x4*)(kml + d0 * 64); kk[d0][1] = *(const LAS f32x4*)(kml + d0 * 64 + 16); }
        const float zm = (r32 < 16) ? 1.f : 0.f;
        f32x16 gg[2];
#pragma unroll
        for (int r = 0; r < 16; ++r) { gg[0][r] = 0.f; gg[1][r] = 0.f; }
#pragma unroll
        for (int d0 = 0; d0 < 4; ++d0) { const f32x4 k0 = kk[d0][0] * zm, k1 = kk[d0][1] * zm; v4u wh, wl;
            wh.x = pk2(k0.x, k0.y); wh.y = pk2(k0.z, k0.w); wh.z = pk2(k1.x, k1.y); wh.w = pk2(k1.z, k1.w);
            wl.x = pk2(k0.x - bflo(wh.x), k0.y - bfhi(wh.x)); wl.y = pk2(k0.z - bflo(wh.y), k0.w - bfhi(wh.y)); wl.z = pk2(k1.x - bflo(wh.z), k1.y - bfhi(wh.z)); wl.w = pk2(k1.z - bflo(wh.w), k1.w - bfhi(wh.w));
#pragma unroll
            for (int g = 0; g < 2; ++g) {
                gg[g] = __builtin_amdgcn_mfma_f32_32x32x16_bf16(__builtin_bit_cast(bf16x8, wh), G[g].qr[d0], gg[g], 0, 0, 0);
                gg[g] = __builtin_amdgcn_mfma_f32_32x32x16_bf16(__builtin_bit_cast(bf16x8, wl), G[g].qr[d0], gg[g], 0, 0, 0); }
        }
#pragma unroll
        for (int g = 0; g < 2; ++g) {
            const f32x16 ga = gg[g];
            float pg[8];
#pragma unroll
            for (int r = 0; r < 8; ++r) pg[r] = __shfl_xor(ga[r], 32);
            float GV[16];
#pragma unroll
            for (int blk = 0; blk < 16; ++blk) { const int q4 = blk >> 2, reg = (blk & 3) + 4 * (q4 >> 1); GV[blk] = ((q4 & 1) == hi) ? ga[reg] : pg[reg]; }
            unsigned selmask = 0u;
#pragma unroll
            for (int it = 0; it < 3; ++it) { float best = -INFINITY; int bi = -1;
#pragma unroll
                for (int blk = 0; blk < 16; ++blk) { const bool ok = (blk < qb) && !((selmask >> blk) & 1u) && (GV[blk] > best); best = ok ? GV[blk] : best; bi = ok ? blk : bi; }
                if (bi >= 0) selmask |= 1u << bi; }
            G[g].sel = selmask;
        }
    }
#pragma unroll
    for (int g = 0; g < 2; ++g)
#pragma unroll
        for (int r = 0; r < 16; ++r) { G[g].o0[r] = 0.f; G[g].o1[r] = 0.f; if (MODE == 1 && AT_MSUM) osum[r] = 0.f; }
    int cur = 0;
#define AT_STAGE_BEGIN(JS) \
        const bool more0 = (JS) - 2 >= jt_lo, more1 = (JS) - 3 >= jt_lo; \
        if (more0) { kst0 = *(const GAS v4u*)(kg + (size_t)(((JS) - 2) * 64) * 256); vst0 = *(const GAS v4u*)(vg + (size_t)(((JS) - 2) * 64) * (AT_VTR ? 256 : 1)); } \
        if (more1) { kst1 = *(const GAS v4u*)(kg + (size_t)(((JS) - 3) * 64) * 256); vst1 = *(const GAS v4u*)(vg + (size_t)(((JS) - 3) * 64) * (AT_VTR ? 256 : 1)); } \
        if (wid >= 4) __builtin_amdgcn_s_sleep(AT_SKEW);
#define AT_STAGE_END() \
        { LAS unsigned char* nb = lds + (cur ^ 1) * AT_STAGEB; \
          if (more0) { *(LAS v4u*)(nb + sdst) = kst0; *(LAS v4u*)(nb + AT_TILEB + sdstv) = vst0; } \
          if (more1) { *(LAS v4u*)(nb + AT_BUFB + sdst) = kst1; *(LAS v4u*)(nb + AT_BUFB + AT_TILEB + sdstv) = vst1; } } \
        __syncthreads(); \
        cur ^= 1;
    {
        const int js = jt_hi;
        AT_STAGE_BEGIN(js)
#pragma unroll
        for (int u = 0; u < 2; ++u) {
            const int jt = js - u;
            if (jt < jt_lo) break;
            const int s0 = jt * 64;
            const LAS unsigned char* buf = lds + cur * AT_STAGEB + u * AT_BUFB;
            const bool first = (u == 0);
            float smg = 1e30f;
            if (u == 1 && ATTN_STEADY && (EXPT == 0 || EXPT >= 3)) {
                if (EXPT != 6 && !((float)(s0 + 63) < smin_w)) {
                    f32x16 pe, po; float me, mo;
                    ST_HEAD(G[0], t0, jt, 0, buf, pe, me);
                    ST_JOIN(G[1], t0 + 32, jt, 0, buf, po, mo, G[0], 0, buf, pe);
                    ST_JOIN(G[0], t0, jt, 1, buf, pe, me, G[1], 0, buf, po);
                    ST_JOIN(G[1], t0 + 32, jt, 1, buf, po, mo, G[0], 1, buf, pe);
                    ST_TAIL(G[1], 1, buf, po);
                }
            } else
            if (EXPT != 2 && !((float)(s0 + 63) < smin_w)) {
#pragma unroll
              for (int g = 0; g < 2; ++g) {
                AttnGrp& A = G[g];
                const int t0g = t0 + 32 * g;
                bool sel = true;
                if (MODE == 1) { const int j = jt >> 2; sel = (j == qb) || ((A.sel >> j) & 1u); }
                if (__any(sel)) {
                    const bool dead1 = first && g == 0;
                    const float base = sel ? slope2 * (float)(s0 + 8 * hi - t0g - r32) - A.mref : -INFINITY;
                    f32x16 p0, p1;
#pragma unroll
                    for (int r = 0; r < 16; ++r) { const float c = (float)(16 * (r >> 3) + (r & 7)); p0[r] = __builtin_fmaf(slope2, c, base); p1[r] = dead1 ? -INFINITY : __builtin_fmaf(slope2, c + 32.f, base); }
#pragma unroll
                    for (int d0 = 0; d0 < 4; ++d0) {
                        const bf16x8 ka = *(const LAS bf16x8*)(buf + kfo + d0 * 32);
                        p0 = __builtin_amdgcn_mfma_f32_32x32x16_bf16(ka, A.qr[d0], p0, 0, 0, 0);
                        if (!dead1) { const bf16x8 kb2 = *(const LAS bf16x8*)(buf + kfo + 32 * AT_ROWB + d0 * 32); p1 = __builtin_amdgcn_mfma_f32_32x32x16_bf16(kb2, A.qr[d0], p1, 0, 0, 0); }
                    }
                    const bool wnd = !first && (MODE == 0 && s0 < t0g - 96);
                    if (first || wnd) {
                        const int dq = t0g + r32 - s0 - 8 * hi;
#pragma unroll
                        for (int r = 0; r < 16; ++r) { const int c = 16 * (r >> 3) + (r & 7); const int e0 = dq - c, e1 = dq - c - 32;
                            const bool v0 = (e0 >= 0) && (MODE == 1 || e0 < 128), v1 = (e1 >= 0) && (MODE == 1 || e1 < 128);
                            if (wnd || g == 0) p0[r] = v0 ? p0[r] : -INFINITY;
                            if (wnd || g == 1) p1[r] = v1 ? p1[r] : -INFINITY; }
                    }
                    float mt, mu;
                    if (dead1) { mt = __builtin_fmaxf(__builtin_fmaxf(p0[0], p0[1]), p0[2]); mu = __builtin_fmaxf(__builtin_fmaxf(p0[3], p0[4]), p0[5]);
#pragma unroll
                        for (int r = 6; r < 16; r += 2) { mt = __builtin_fmaxf(mt, p0[r]); mu = __builtin_fmaxf(mu, p0[r + 1]); } }
                    else { mt = __builtin_fmaxf(__builtin_fmaxf(p0[0], p0[1]), p1[0]); mu = __builtin_fmaxf(__builtin_fmaxf(p0[2], p0[3]), p1[1]); mt = __builtin_fmaxf(__builtin_fmaxf(mt, p1[2]), p1[3]);
#pragma unroll
                        for (int r = 4; r < 16; r += 4) { mt = __builtin_fmaxf(__builtin_fmaxf(mt, p0[r]), p0[r + 1]); mu = __builtin_fmaxf(__builtin_fmaxf(mu, p0[r + 2]), p0[r + 3]); mt = __builtin_fmaxf(__builtin_fmaxf(mt, p1[r]), p1[r + 1]); mu = __builtin_fmaxf(__builtin_fmaxf(mu, p1[r + 2]), p1[r + 3]); } }
                    mt = __builtin_fmaxf(mt, mu);
                    if (first || __any(mt > 8.0f)) {
                        const float m2 = __builtin_fmaxf(mt, __shfl_xor(mt, 32));
                        const float dl = first ? m2 : ((m2 > 8.0f) ? m2 : 0.f);
                        A.mref += dl;
                        const float alpha = __builtin_amdgcn_exp2f(-dl);
                        if (!first) { A.lrow *= alpha;
#pragma unroll
                            for (int r = 0; r < 16; ++r) { A.o0[r] *= alpha; A.o1[r] *= alpha; } }
#pragma unroll
                        for (int r = 0; r < 16; ++r) { p0[r] -= dl; if (!dead1) p1[r] -= dl; }
                        mt -= dl;
                    }
                    if (first) smg = fminf(smg, (float)(t0g + r32) - (40.0f + A.cs - A.mref) / slope2);
                    if (EXPT != 1 && !__all(mt < -40.0f)) {
                        float ls = 0.f;
#pragma unroll
                        for (int r = 0; r < 16; ++r) { p0[r] = __builtin_amdgcn_exp2f(p0[r]); if (dead1) ls += p0[r]; else { p1[r] = __builtin_amdgcn_exp2f(p1[r]); ls += p0[r] + p1[r]; } }
                        A.lrow += ls;
#pragma unroll
                        for (int hf = 0; hf < (dead1 ? 1 : 2); ++hf)
#pragma unroll
                            for (int sp = 0; sp < 2; ++sp) {
                                v4u pw;
                                if (hf == 0) { pw.x = cvtpk(p0[8 * sp + 0], p0[8 * sp + 1]); pw.y = cvtpk(p0[8 * sp + 2], p0[8 * sp + 3]); pw.z = cvtpk(p0[8 * sp + 4], p0[8 * sp + 5]); pw.w = cvtpk(p0[8 * sp + 6], p0[8 * sp + 7]); }
                                else         { pw.x = cvtpk(p1[8 * sp + 0], p1[8 * sp + 1]); pw.y = cvtpk(p1[8 * sp + 2], p1[8 * sp + 3]); pw.z = cvtpk(p1[8 * sp + 4], p1[8 * sp + 5]); pw.w = cvtpk(p1[8 * sp + 6], p1[8 * sp + 7]); }
                                const bf16x8 pb = __builtin_bit_cast(bf16x8, pw);
                                const bf16x8 va = ST_V(buf, hf, sp, 0), vb = ST_V(buf, hf, sp, 1);
                                A.o0 = __builtin_amdgcn_mfma_f32_32x32x16_bf16(va, pb, A.o0, 0, 0, 0);
                                A.o1 = __builtin_amdgcn_mfma_f32_32x32x16_bf16(vb, pb, A.o1, 0, 0, 0);
                            }
                    }
                }
              }
            }
            if (first && EXPT != 2) {
                float sm = smg;
#pragma unroll
                for (int o = 1; o < 64; o <<= 1) sm = fminf(sm, __shfl_xor(sm, o));
                smin_w = sm;
                if (lane == 0) *(LAS float*)(lds + 2 * AT_STAGEB + wid * 4) = sm;
            }
        }
        AT_STAGE_END()
        if (EXPT != 2) {
            const LAS float* cw = (const LAS float*)(lds + 2 * AT_STAGEB);
            float sm = fminf(fminf(fminf(cw[0], cw[1]), fminf(cw[2], cw[3])), fminf(fminf(cw[4], cw[5]), fminf(cw[6], cw[7])));
            sm = fminf(fmaxf(sm, 0.f), 4096.f);
            const int jc = __builtin_amdgcn_readfirstlane((int)(sm * (1.0f / 64.0f)));
            jt_lo = jc > jt_lo ? jc : jt_lo;
            if (EXPT == 8 || EXPT == 9) jt_lo = jt_hi + 1;
        }
    }
    for (int js = jt_hi - 2; js >= jt_lo; js -= 2) {
        AT_STAGE_BEGIN(js)
        if (MODE == 1 && (EXPT == 0 || EXPT >= 3) && ATTN_STEADY) {
            if (EXPT != 6 && !((float)(js * 64 + 63) < smin_w)) {
                const LAS unsigned char* b0 = lds + cur * AT_STAGEB; const LAS unsigned char* b1 = b0 + AT_BUFB;
                f32x16 pe, po; float me, mo;
                ST_HEAD(G[0], t0, js, 0, b0, pe, me);
                ST_JOIN(G[1], t0 + 32, js, 0, b0, po, mo, G[0], 0, b0, pe);
                ST_JOIN(G[0], t0, js, 1, b0, pe, me, G[1], 0, b0, po);
                ST_JOIN(G[1], t0 + 32, js, 1, b0, po, mo, G[0], 1, b0, pe);
                if (js - 1 >= jt_lo) {
                    ST_JOIN(G[0], t0, js - 1, 0, b1, pe, me, G[1], 1, b0, po);
                    ST_JOIN(G[1], t0 + 32, js - 1, 0, b1, po, mo, G[0], 0, b1, pe);
                    ST_JOIN(G[0], t0, js - 1, 1, b1, pe, me, G[1], 0, b1, po);
                    ST_JOIN(G[1], t0 + 32, js - 1, 1, b1, po, mo, G[0], 1, b1, pe);
                    ST_TAIL(G[1], 1, b1, po);
                } else {
                    ST_TAIL(G[1], 1, b0, po);
                }
            }
        }
        else {
#pragma unroll
        for (int u = 0; u < 2; ++u) {
            const int jt = js - u;
            if (jt < jt_lo) break;
            const int s0 = jt * 64;
            const LAS unsigned char* buf = lds + cur * AT_STAGEB + u * AT_BUFB;
            const bool first = (jt == jt_hi);
            float smg = 1e30f;
            if (EXPT != 2 && !((float)(s0 + 63) < smin_w)) {
#pragma unroll
              for (int g = 0; g < 2; ++g) {
                AttnGrp& A = G[g];
                const int t0g = t0 + 32 * g;
                bool sel = true;
                if (MODE == 1) { const int j = jt >> 2; sel = (j == qb) || ((A.sel >> j) & 1u); }
                if (__any(sel)) {
                    const float base = sel ? slope2 * (float)(s0 + 8 * hi - t0g - r32) - A.mref : -INFINITY;
                    f32x16 p0, p1;
#pragma unroll
                    for (int r = 0; r < 16; ++r) { const float c = (float)(16 * (r >> 3) + (r & 7)); p0[r] = __builtin_fmaf(slope2, c, base); p1[r] = __builtin_fmaf(slope2, c + 32.f, base); }
#pragma unroll
                    for (int d0 = 0; d0 < 4; ++d0) {
                        const bf16x8 ka = *(const LAS bf16x8*)(buf + kfo + d0 * 32), kb2 = *(const LAS bf16x8*)(buf + kfo + 32 * AT_ROWB + d0 * 32);
                        p0 = __builtin_amdgcn_mfma_f32_32x32x16_bf16(ka, A.qr[d0], p0, 0, 0, 0);
                        p1 = __builtin_amdgcn_mfma_f32_32x32x16_bf16(kb2, A.qr[d0], p1, 0, 0, 0);
                    }
                    if (first || (MODE == 0 && s0 < t0g - 96)) {
                        const int dq = t0g + r32 - s0 - 8 * hi;
#pragma unroll
                        for (int r = 0; r < 16; ++r) { const int c = 16 * (r >> 3) + (r & 7); const int e0 = dq - c, e1 = dq - c - 32;
                            const bool v0 = (e0 >= 0) && (MODE == 1 || e0 < 128), v1 = (e1 >= 0) && (MODE == 1 || e1 < 128);
                            p0[r] = v0 ? p0[r] : -INFINITY; p1[r] = v1 ? p1[r] : -INFINITY; }
                    }
                    float mt = __builtin_fmaxf(__builtin_fmaxf(p0[0], p0[1]), p1[0]); float mu = __builtin_fmaxf(__builtin_fmaxf(p0[2], p0[3]), p1[1]); mt = __builtin_fmaxf(__builtin_fmaxf(mt, p1[2]), p1[3]);
#pragma unroll
                    for (int r = 4; r < 16; r += 4) { mt = __builtin_fmaxf(__builtin_fmaxf(mt, p0[r]), p0[r + 1]); mu = __builtin_fmaxf(__builtin_fmaxf(mu, p0[r + 2]), p0[r + 3]); mt = __builtin_fmaxf(__builtin_fmaxf(mt, p1[r]), p1[r + 1]); mu = __builtin_fmaxf(__builtin_fmaxf(mu, p1[r + 2]), p1[r + 3]); }
                    mt = __builtin_fmaxf(mt, mu);
                    if (first || __any(mt > 8.0f)) {
                        const float m2 = __builtin_fmaxf(mt, __shfl_xor(mt, 32));
                        const float dl = first ? m2 : ((m2 > 8.0f) ? m2 : 0.f);
                        A.mref += dl;
                        const float alpha = __builtin_amdgcn_exp2f(-dl);
                        A.lrow *= alpha;
#pragma unroll
                        for (int r = 0; r < 16; ++r) { A.o0[r] *= alpha; A.o1[r] *= alpha; p0[r] -= dl; p1[r] -= dl; }
                        mt -= dl;
                    }
                    if (first) smg = fminf(smg, (float)(t0g + r32) - (40.0f + A.cs - A.mref) / slope2);
                    if (EXPT != 1 && !__all(mt < -40.0f)) {
                        float ls = 0.f;
#pragma unroll
                        for (int r = 0; r < 16; ++r) { p0[r] = __builtin_amdgcn_exp2f(p0[r]); p1[r] = __builtin_amdgcn_exp2f(p1[r]); ls += p0[r] + p1[r]; }
                        A.lrow += ls;
#pragma unroll
                        for (int hf = 0; hf < 2; ++hf)
#pragma unroll
                            for (int sp = 0; sp < 2; ++sp) {
                                v4u pw;
                                if (hf == 0) { pw.x = cvtpk(p0[8 * sp + 0], p0[8 * sp + 1]); pw.y = cvtpk(p0[8 * sp + 2], p0[8 * sp + 3]); pw.z = cvtpk(p0[8 * sp + 4], p0[8 * sp + 5]); pw.w = cvtpk(p0[8 * sp + 6], p0[8 * sp + 7]); }
                                else         { pw.x = cvtpk(p1[8 * sp + 0], p1[8 * sp + 1]); pw.y = cvtpk(p1[8 * sp + 2], p1[8 * sp + 3]); pw.z = cvtpk(p1[8 * sp + 4], p1[8 * sp + 5]); pw.w = cvtpk(p1[8 * sp + 6], p1[8 * sp + 7]); }
                                const bf16x8 pb = __builtin_bit_cast(bf16x8, pw);
                                const bf16x8 va = ST_V(buf, hf, sp, 0), vb = ST_V(buf, hf, sp, 1);
                                A.o0 = __builtin_amdgcn_mfma_f32_32x32x16_bf16(va, pb, A.o0, 0, 0, 0);
                                A.o1 = __builtin_amdgcn_mfma_f32_32x32x16_bf16(vb, pb, A.o1, 0, 0, 0);
                            }
                    }
                }
              }
            }
            if (first && EXPT != 2) {
                float sm = smg;
#pragma unroll
                for (int o = 1; o < 64; o <<= 1) sm = fminf(sm, __shfl_xor(sm, o));
                smin_w = sm;
                if (lane == 0) *(LAS float*)(lds + 2 * AT_STAGEB + wid * 4) = sm;
            }
        }
        }
        AT_STAGE_END()
    }
#undef AT_STAGE_BEGIN
#undef AT_STAGE_END
    if (AT_EARLY_PREFETCH && un + 1 < 4) { AT_UNIT_DESC(un + 1, nb_, nk_, ng_) AT_UNIT_LOADS(nb_, nk_, ng_); }
#pragma unroll
    for (int g = 0; g < 2; ++g) {
        if (!AT_EARLY_PREFETCH && g == 1 && un + 1 < 4) { AT_UNIT_DESC(un + 1, nb_, nk_, ng_) AT_UNIT_LOADS(nb_, nk_, ng_); }
        float lt = G[g].lrow + __shfl_xor(G[g].lrow, 32);
        if (MODE == 1 && AT_MSUM) lt += osum[8 * g];
        if (MODE == 0) lt += __builtin_amdgcn_exp2f(sinks[h] * LOG2E - G[g].mref);
        const float inv = 1.0f / lt;
        const size_t orow = rowbase + t0 + 32 * g + r32;
        bf16* Ow = QO_BLK ? OB + ((size_t)((orow >> 8) * 8 + (h >> 2)) * 256 + (orow & 255)) * 256 + (h & 3) * 64 + 8 * hi : OB + orow * D + h * HD + 8 * hi;
#pragma unroll
        for (int i = 0; i < 2; ++i) {
#pragma unroll
            for (int hf2 = 0; hf2 < 2; ++hf2) {
                float keep[4], send[4], recv[4];
#pragma unroll
                for (int e = 0; e < 4; ++e) { const float va = (hf2 ? G[g].o1[8 * i + e] : G[g].o0[8 * i + e]) * inv, vb = (hf2 ? G[g].o1[8 * i + 4 + e] : G[g].o0[8 * i + 4 + e]) * inv;
                    keep[e] = hi ? vb : va; send[e] = hi ? va : vb; }
#pragma unroll
                for (int e = 0; e < 4; ++e) recv[e] = __shfl_xor(send[e], 32);
                v4u w;
                if (hi == 0) { w.x = cvtpk(keep[0], keep[1]); w.y = cvtpk(keep[2], keep[3]); w.z = cvtpk(recv[0], recv[1]); w.w = cvtpk(recv[2], recv[3]); }
                else         { w.x = cvtpk(recv[0], recv[1]); w.y = cvtpk(recv[2], recv[3]); w.z = cvtpk(keep[0], keep[1]); w.w = cvtpk(keep[2], keep[3]); }
                *(GAS v4u*)(Ow + 32 * hf2 + 16 * i) = w;
            }
        }
    }
    }
#undef AT_UNIT_LOADS
}
template <int MODE, int EXPT = 0>
__device__ __forceinline__ void attn_phase(Frame& F, const bf16* QO, bf16* OB, const bf16* Kb, const bf16* Vt, const float* kmean, const float* kmaxp, const float* sinks) {
    if (AT_PRIO && F.wave >= 4) __builtin_amdgcn_s_setprio(1);
    for (int v = F.vcu; v < 256; v += F.G) attn_units<MODE, EXPT>(F.wave, v, QO, OB, Kb, Vt, kmean, kmaxp, sinks, F.lds + RING_OFF);
    if (AT_PRIO) __builtin_amdgcn_s_setprio(0);
}
struct WSrc { unsigned* cmax; const float* w_qkv_a; const float* w_o_a; const float* kv_norm; const float* w_kv; const float* w_q_b; const float* w_o_b; const float* n_attn_pre; const float* n_mlp_pre; const float* w_up; const float* w_down; };
constexpr int CV_QKV = (D / 64) * (NQKV / 32), CV_O = (D / 64) * (D / 32), CV_UP = (D / 64) * (FF / 32), CV_DN = (FF / 64) * (D / 32), CV_KV = (D / 64) * (512 / 32);
constexpr int CV_L0 = CV_QKV + CV_O + CV_UP + CV_DN, CV_ALL = CV_L0 + CV_O + CV_KV + CV_O + CV_UP + CV_DN;
#ifndef CMAX_SAMPLE
#define CMAX_SAMPLE 8
#endif
constexpr int CV_UPS = CV_UP / CMAX_SAMPLE;
#ifndef SLOT_DN0
#define SLOT_DN0 1
#endif
#ifndef SLOT_MOVE
#define SLOT_MOVE 0
#endif
#ifndef SLOT_BAL
#define SLOT_BAL 1
#endif
constexpr int CV_P0 = SLOT_MOVE ? CV_QKV : CV_QKV + CV_O, CV_P1 = CV_L0 + CV_O + CV_KV + (SLOT_BAL ? CV_O + CV_UP / 4 : 0);
__device__ __forceinline__ CvItem cv_decode(const WSrc& W, bf16* Wb, int it) {
    bf16* W0 = Wb; bf16* W1 = Wb + W_LAYER / 2; int r = it;
    if (r < CV_QKV) return CvItem{W.w_qkv_a, W.n_attn_pre, W0, D, NQKV, 0, r, 0.f, nullptr, 0}; r -= CV_QKV;
    if (r < CV_O)   return CvItem{W.w_o_a, nullptr, W0 + W_QKV / 2, D, D, 0, r, 0.f, nullptr, 0}; r -= CV_O;
    if (r < CV_UP)  return CvItem{W.w_up, W.n_mlp_pre, W0 + (W_QKV + W_O) / 2, D, FF, 0, r, 0.f, I8_UP0 ? W.cmax + FF : nullptr, I8_UP0}; r -= CV_UP;
    if (r < CV_DN)  return CvItem{W.w_down, nullptr, W0 + (W_QKV + W_O + W_UP) / 2, FF, D, 0, r, 0.f, nullptr, 0}; r -= CV_DN;
    if (r < CV_O)   return CvItem{W.w_q_b, W.n_attn_pre + D, W1, D, D, 0, r, 0.f, nullptr, 0}; r -= CV_O;
    if (r < CV_KV)  return CvItem{W.w_kv, W.kv_norm, W1, D, 512, 2048, r, 0.f, nullptr, 0}; r -= CV_KV;
    if (r < CV_O)   return CvItem{W.w_o_b, nullptr, W1 + W_QKV / 2, D, D, 0, r, 0.f, nullptr, 0}; r -= CV_O;
    if (r < CV_UP)  return CvItem{W.w_up + (size_t)D * FF, W.n_mlp_pre + D, W1 + (W_QKV + W_O) / 2, D, FF, 0, r, 0.f, (I8_UP1 && I8_TEST != 2) ? W.cmax : nullptr, (I8_UP1 && I8_TEST != 2) ? 1 : 0}; r -= CV_UP;
    if (r < CV_DN)  return CvItem{W.w_down + (size_t)FF * D, nullptr, W1 + (W_QKV + W_O + W_UP) / 2, FF, D, 0, r, FP8_DOWN1 ? pg8::FP8_WSCALE : 0.f, nullptr, 0}; r -= CV_DN;
    constexpr int NB_ = FF / 32;
    if (r < CV_UPS) return CvItem{W.w_up + (size_t)D * FF, W.n_mlp_pre + D, nullptr, D, FF, 0, (r / NB_) * CMAX_SAMPLE * NB_ + r % NB_, 0.f, W.cmax, 0}; r -= CV_UPS;
    return CvItem{W.w_up, W.n_mlp_pre, nullptr, D, FF, 0, (r / NB_) * CMAX_SAMPLE * NB_ + r % NB_, 0.f, W.cmax + FF, 0};
    return CvItem{W.w_down + (size_t)FF * D, nullptr, W1 + (W_QKV + W_O + W_UP) / 2, FF, D, 0, r, FP8_DOWN1 ? pg8::FP8_WSCALE : 0.f, nullptr, 0};
}
__device__ __forceinline__ void convert_weights(const WSrc& W, bf16* Wb, int it0, int it1, int gw, int NGW, LAS unsigned char* ldsbase, int wave, int lane_unused, int x0 = 0, int xn = 0) {
    const int lane = pg8::lane_now();
    LAS float* scr = (LAS float*)(ldsbase + wave * 16384);
    const int n1 = it1 - it0, ntot = n1 + xn;
#define CV_ID(k_) ((k_) < n1 ? it0 + (k_) : x0 + ((k_) - n1))
    int it = gw; if (it >= ntot) return;
    CvItem cur = cv_decode(W, Wb, CV_ID(it)); f32x4 va[8], vb[8];
    cv_load(cur, va, lane);
    for (;;) {
        const int nx = it + NGW; const bool more = nx < ntot; CvItem nxt = cur;
        if (more) { nxt = cv_decode(W, Wb, CV_ID(nx)); cv_load(nxt, vb, lane); }
        cv_finish(cur, va, scr, lane);
        if (!more) break;
#pragma unroll
        for (int i = 0; i < 8; ++i) va[i] = vb[i];
        cur = nxt; it = nx;
    }
#undef CV_ID
}
struct LayerCtx { const WSrc* W; float* RS; const float* x; float* out; const float* sinks_a; const float* n_attn_post; const float* n_mlp_post; bf16* Wb; bf16* QO; bf16* HB; bf16* XN; bf16* KB; bf16* VT; float* KMEAN; int lo, hi; };
#define GRID_BAR() do { if (N_LAUNCHES == 1) xcd_barrier(bar); } while (0)
#define GEMM_SKEW(N_) do { if ((N_) > 0) { const int g_ = F.vcu & 3; for (int i_ = 0; i_ < g_; ++i_) __builtin_amdgcn_s_sleep(N_); } } while (0)
#define IN(k) (lo <= (k) && (k) < hi)
#define BOTH(k) (IN(k) && IN((k) + 1))
#ifndef MLP_SPLIT1
#define MLP_SPLIT1 0
#endif
#ifndef MLP_SPLIT
#define MLP_SPLIT 1
#endif
template <int HALF_, int L_>
__device__ __forceinline__ void mlp_half_l0(Frame& F, const XcdBarrier& bar, const float* RS, const signed char* XQ, bf16* Wup, const unsigned* cmx, bf16* HB, bf16* Wdn, bf16* YB) {
    constexpr int MH = M / 2; const size_t r0 = (size_t)HALF_ * MH;
    {
        pg8::StaticOrder S; S.init(MH, FF, F.G, (int)blockIdx.x);
        { pg8::Unit pu; LAS float* rsl = (LAS float*)(F.lds + RSL_OFF); LAS float* cml = (LAS float*)(F.lds + CML_OFF);
          int tl_ = pg8::wave_tid(F.wave); asm volatile("" : "+v"(tl_));
          for (int i0 = 0; i0 < 8; i0 += 2) { const int i = i0 + (tl_ >> 8); if (S.next(i, pu)) { rsl[i * 256 + (tl_ & 255)] = RS[r0 + pu.pm * 256 + (tl_ & 255)];
              cml[i * 256 + (tl_ & 255)] = __builtin_bit_cast(float, cmx[pu.pn * 256 + (tl_ & 255)]) * (1.0f / 127.0f); } }
          __syncthreads(); }
        pg8::Gemm g8{(const pg8::bf16_t*)(XQ + r0 * D), Wup, MH, FF, D / 2};
        if constexpr (L_ == 0) {
        pg8::EpiBf16<2, false, H_BLK> E{HB + r0 * FF, FF, (const LAS float*)(F.lds + RSL_OFF), 1.0f, cmx, (const LAS float*)(F.lds + CML_OFF)};
        pg8::gemm_phase<pg8::EpiBf16<2, false, H_BLK>, pg8::StaticOrder, PG8_ALIGN, PG8_SP2, false, true, 0, W_LIN>(F.lds + RING_OFF, g8, S, E, F.wave);
        } else {
        pg8::EpiBf16<3, false, H_BLK> E{(bf16*)((unsigned char*)HB + r0 * FF), FF, (const LAS float*)(F.lds + RSL_OFF), 1.0f, cmx, (const LAS float*)(F.lds + CML_OFF)};
        pg8::gemm_phase<pg8::EpiBf16<3, false, H_BLK>, pg8::StaticOrder, PG8_ALIGN, PG8_SP2, false, true, 0, W_LIN>(F.lds + RING_OFF, g8, S, E, F.wave);
        }
        GRID_BAR();
    }
    {
        pg8::StaticOrder S; S.init(MH, D, F.G, (int)blockIdx.x);
        if constexpr (L_ == 0) {
        pg8::Gemm g{HB + r0 * FF, Wdn, MH, D, FF};
        pg8::EpiBf16<0, false, Y_BLK> E{YB + r0 * D, D, nullptr, 1.0f, nullptr};
        pg8::gemm_phase<pg8::EpiBf16<0, false, Y_BLK>, pg8::StaticOrder, PG8_ALIGN, PG8_SP2, false, false, H_BLK == 2 ? -1 : H_BLK ? 512 : 0, W_LIN>(F.lds + RING_OFF, g, S, E, F.wave);
        } else {
        pg8::Gemm g{(bf16*)((unsigned char*)HB + r0 * FF), Wdn, MH, D, FF / 2};
        pg8::EpiBf16<0, false, Y_BLK> E{YB + r0 * D, D, nullptr, 1.0f / (pg8::FP8_HSCALE * pg8::FP8_WSCALE), nullptr};
        pg8::gemm_phase<pg8::EpiBf16<0, false, Y_BLK>, pg8::StaticOrder, PG8_ALIGN, PG8_SP2, true, false, H_BLK == 2 ? -1 : H_BLK ? 256 : 0, W_LIN>(F.lds + RING_OFF, g, S, E, F.wave);
        }
        GRID_BAR();
    }
}
template <int l>
__device__ __forceinline__ void layer_phases(Frame& F, const XcdBarrier& bar, const LayerCtx& C) {
    const WSrc& W = *C.W; float* RS = C.RS; const float* x = C.x; float* out = C.out; const float* sinks_a = C.sinks_a; const float* n_attn_post = C.n_attn_post; const float* n_mlp_post = C.n_mlp_post;
    bf16* Wb = C.Wb; bf16* QO = C.QO; bf16* HB = C.HB; bf16* XN = C.XN; bf16* KB = C.KB; bf16* VT = C.VT; float* KMEAN = C.KMEAN; const int lo = C.lo, hi = C.hi;
        const int pb = 1 + 7 * l;
        bf16* WL = Wb + (size_t)l * (W_LAYER / 2);
        bf16* Wqkv = WL; bf16* Wo = WL + W_QKV / 2; bf16* Wup = WL + (W_QKV + W_O) / 2; bf16* Wdn = WL + (W_QKV + W_O + W_UP) / 2;
        bf16* YB = (l == 0) ? (bf16*)out : Wb;
        if (IN(pb)) {
            pg8::Gemm g{XN, Wqkv, M, NQKV, D}; pg8::StaticOrder S; S.init(M, NQKV, F.G, (int)blockIdx.x);
            { pg8::Unit pu; LAS float* rsl = (LAS float*)(F.lds + RSL_OFF);
              int tl_ = pg8::wave_tid(F.wave); asm volatile("" : "+v"(tl_));
              for (int i0 = 0; i0 < 8; i0 += 2) { const int i = i0 + (tl_ >> 8); if (S.next(i, pu)) rsl[i * 256 + (tl_ & 255)] = RS[pu.pm * 256 + (tl_ & 255)]; }
              __syncthreads(); }
            pg8::EpiQKV E{QO, KB, KMEAN, l, QSCALE, (const LAS float*)(F.lds + RSL_OFF)};
            GEMM_SKEW(SKEW_QKV);
            if (PROBE_DUP == 2 && l == 0) { pg8::gemm_phase<pg8::EpiQKV, pg8::StaticOrder, PG8_ALIGN, PG8_SP2, false, false, 0, W_LIN>(F.lds + RING_OFF, g, S, E, F.wave); __syncthreads(); }
            pg8::gemm_phase<pg8::EpiQKV, pg8::StaticOrder, PG8_ALIGN, PG8_SP2, false, false, 0, W_LIN>(F.lds + RING_OFF, g, S, E, F.wave);
            {
                constexpr int CV_D0 = CV_QKV + CV_O + CV_UP;
                const int c0 = (l == 0) ? CV_P0 : CV_P1, c1 = (l == 0) ? ((SLOT_DN0 && !SLOT_MOVE) ? CV_D0 : CV_P1) : CV_ALL;
                const int nshort = (int)F.G - (M / 256 * (NQKV / 256)) % (int)F.G, sb = (int)blockIdx.x - ((int)F.G - nshort);
                const int xn = (SLOT_MOVE && I8_UP1 && l == 0) ? CV_UPS : (SLOT_DN0 && l == 0) ? CV_P1 - CV_L0 : 0;
                const int x0 = (SLOT_DN0 && !SLOT_MOVE && l == 0) ? CV_L0 : CV_ALL;
                if (nshort < (int)F.G && sb >= 0) convert_weights(W, Wb, c0, c1, sb * NWAVES + F.wave, nshort * NWAVES, F.lds + RING_OFF, F.wave, F.lane, x0, xn);
                else if (nshort == (int)F.G) convert_weights(W, Wb, c0, c1, (int)blockIdx.x * NWAVES + F.wave, (int)F.G * NWAVES, F.lds + RING_OFF, F.wave, F.lane, x0, xn);
                VM_WAIT(); __syncthreads();
            }
            if (BOTH(pb)) GRID_BAR();
        }
        if (IN(pb + 1)) {
            if (PROBE_DUP == 3 + 3 * l) { if (l == 0) attn_phase<0>(F, QO, HB + (size_t)M * D, KB, VT, nullptr, KMEAN + 64 * 256 + 64 * l, sinks_a); else attn_phase<1, PROBE_EXPT>(F, QO, HB + (size_t)M * D, KB, VT, KMEAN, KMEAN + 64 * 256 + 64 * l, nullptr); __syncthreads(); }
            if (l == 0) attn_phase<0>(F, QO, QO, KB, VT, nullptr, KMEAN + 64 * 256 + 64 * l, sinks_a);
            else        attn_phase<1>(F, QO, QO, KB, VT, KMEAN, KMEAN + 64 * 256 + 64 * l, nullptr);
            if (BOTH(pb + 1)) GRID_BAR();
        }
        if (IN(pb + 2)) {
            pg8::Gemm g{QO, Wo, M, D, D}; pg8::StaticOrder S; S.init(M, D, F.G, (int)blockIdx.x);
            pg8::EpiBf16<0, false, Y_BLK> E{YB, D, nullptr, 1.0f, nullptr};
            GEMM_SKEW(SKEW_O);
            if (PROBE_DUP == 8 && l == 0) { pg8::gemm_phase<pg8::EpiBf16<0, false, Y_BLK>, pg8::StaticOrder, PG8_ALIGN, PG8_SP2, false, false, QO_BLK ? 512 : 0, W_LIN, false>(F.lds + RING_OFF, g, S, E, F.wave);     __syncthreads(); }
            pg8::gemm_phase<pg8::EpiBf16<0, false, Y_BLK>, pg8::StaticOrder, PG8_ALIGN, PG8_SP2, false, false, QO_BLK ? 512 : 0, W_LIN, false>(F.lds + RING_OFF, g, S, E, F.wave);
            if (BOTH(pb + 2)) GRID_BAR();
        }
        if (IN(pb + 3)) {
            thin_phase<false>(F, YB, nullptr, XN, RS, nullptr, n_attn_post + l * D, ((I8_UP1 && I8_TEST != 1 && l == 1) || (I8_UP0 && l == 0)) ? (signed char*)out + XQ_OFF : nullptr);
            if (BOTH(pb + 3)) GRID_BAR();
        }
        constexpr bool split = N_LAUNCHES == 1 && PROBE_DUP == 0 && ((MLP_SPLIT && l == 0 && I8_UP0) || (MLP_SPLIT1 && l == 1 && FP8_DOWN1 && I8_UP1 && I8_TEST == 0));
        if constexpr (split) {
            mlp_half_l0<0, l>(F, bar, RS, (const signed char*)out + XQ_OFF, Wup, (const unsigned*)W.cmax + (l == 0 ? FF : 0), HB, Wdn, YB);
            mlp_half_l0<1, l>(F, bar, RS, (const signed char*)out + XQ_OFF, Wup, (const unsigned*)W.cmax + (l == 0 ? FF : 0), HB, Wdn, YB);
        }
        if (!split && IN(pb + 4)) {
            pg8::Gemm g{XN, Wup, M, FF, D}; pg8::StaticOrder S; S.init(M, FF, F.G, (int)blockIdx.x);
            const unsigned* const cmx = (FP8_DOWN1 && I8_UP1 && I8_TEST == 0 && l == 1) ? (const unsigned*)W.cmax : (I8_UP0 && l == 0) ? (const unsigned*)W.cmax + FF : nullptr;
            { pg8::Unit pu; LAS float* rsl = (LAS float*)(F.lds + RSL_OFF); LAS float* cml = (LAS float*)(F.lds + CML_OFF);
              int tl_ = pg8::wave_tid(F.wave); asm volatile("" : "+v"(tl_));
              for (int i0 = 0; i0 < 8; i0 += 2) { const int i = i0 + (tl_ >> 8); if (S.next(i, pu)) { rsl[i * 256 + (tl_ & 255)] = RS[pu.pm * 256 + (tl_ & 255)];
                  if (cmx) cml[i * 256 + (tl_ & 255)] = __builtin_bit_cast(float, cmx[pu.pn * 256 + (tl_ & 255)]) * (1.0f / 127.0f); } }
              __syncthreads(); }
            GEMM_SKEW(SKEW_UP);
            if (FP8_DOWN1 && I8_UP1 && I8_TEST == 0 && l == 1) {
                pg8::Gemm g8{(const pg8::bf16_t*)((const signed char*)out + XQ_OFF), Wup, M, FF, D / 2};
                pg8::EpiBf16<3, false, H_BLK> E{HB, FF, (const LAS float*)(F.lds + RSL_OFF), 1.0f, (const unsigned*)W.cmax, (const LAS float*)(F.lds + CML_OFF)};
                pg8::gemm_phase<pg8::EpiBf16<3, false, H_BLK>, pg8::StaticOrder, PG8_ALIGN, PG8_SP2, false, true, 0, W_LIN>(F.lds + RING_OFF, g8, S, E, F.wave);
            } else if (I8_UP0 && l == 0) {
                pg8::Gemm g8{(const pg8::bf16_t*)((const signed char*)out + XQ_OFF), Wup, M, FF, D / 2};
                pg8::EpiBf16<2, false, H_BLK> E{HB, FF, (const LAS float*)(F.lds + RSL_OFF), 1.0f, (const unsigned*)W.cmax + FF, (const LAS float*)(F.lds + CML_OFF)};
                if (PROBE_DUP == 15) { pg8::gemm_phase<pg8::EpiBf16<2, false, H_BLK>, pg8::StaticOrder, PG8_ALIGN, PG8_SP2, false, true, 0, W_LIN>(F.lds + RING_OFF, g8, S, E, F.wave); __syncthreads(); }
                if (PROBE_DUP == 17) { pg8::EpiBf16<2, true> EN{HB, FF, (const LAS float*)(F.lds + RSL_OFF), 1.0f, (const unsigned*)W.cmax + FF}; pg8::gemm_phase<pg8::EpiBf16<2, true>, pg8::StaticOrder, PG8_ALIGN, PG8_SP2, false, true, 0, W_LIN>(F.lds + RING_OFF, g8, S, EN, F.wave); __syncthreads(); }
                if (PROBE_DUP == 18) { pg8::EpiBf16<2, false, true> EN{HB, FF, (const LAS float*)(F.lds + RSL_OFF), 1.0f, (const unsigned*)W.cmax + FF}; pg8::gemm_phase<pg8::EpiBf16<2, false, true>, pg8::StaticOrder, PG8_ALIGN, PG8_SP2, false, true, 0, W_LIN>(F.lds + RING_OFF, g8, S, EN, F.wave); __syncthreads(); }
                if (PROBE_DUP == 19) { pg8::EpiBf16<2, false, true, true> EN{HB, FF, (const LAS float*)(F.lds + RSL_OFF), 1.0f, (const unsigned*)W.cmax + FF}; pg8::gemm_phase<pg8::EpiBf16<2, false, true, true>, pg8::StaticOrder, PG8_ALIGN, PG8_SP2, false, true, 0, W_LIN>(F.lds + RING_OFF, g8, S, EN, F.wave); __syncthreads(); }
                if (PROBE_DUP == 21) { pg8::EpiBf16<2, false, true, false, true> EN{HB, FF, (const LAS float*)(F.lds + RSL_OFF), 1.0f, (const unsigned*)W.cmax + FF}; pg8::gemm_phase<pg8::EpiBf16<2, false, true, false, true>, pg8::StaticOrder, PG8_ALIGN, PG8_SP2, false, true, 0, W_LIN>(F.lds + RING_OFF, g8, S, EN, F.wave); __syncthreads(); }
                if (PROBE_DUP == 22) { pg8::EpiBf16<2, false, true, true, true> EN{HB, FF, (const LAS float*)(F.lds + RSL_OFF), 1.0f, (const unsigned*)W.cmax + FF}; pg8::gemm_phase<pg8::EpiBf16<2, false, true, true, true>, pg8::StaticOrder, PG8_ALIGN, PG8_SP2, false, true, 0, W_LIN>(F.lds + RING_OFF, g8, S, EN, F.wave); __syncthreads(); }
                if (PROBE_DUP == 23) { pg8::EpiNull EN; pg8::gemm_phase<pg8::EpiNull, pg8::StaticOrder, PG8_ALIGN, PG8_SP2, false, true, -1, true>(F.lds + RING_OFF, g8, S, EN, F.wave); __syncthreads(); }
                if (PROBE_DUP == 24) { pg8::EpiNull EN; pg8::gemm_phase<pg8::EpiNull, pg8::StaticOrder, PG8_ALIGN, PG8_SP2, false, true, 0, true>(F.lds + RING_OFF, g8, S, EN, F.wave); __syncthreads(); }
                if (PROBE_DUP == 25) { pg8::EpiNull EN; pg8::gemm_phase<pg8::EpiNull, pg8::StaticOrder, PG8_ALIGN, PG8_SP2, false, true, -1, W_LIN>(F.lds + RING_OFF, g8, S, EN, F.wave); __syncthreads(); }
                if (PROBE_DUP == 16) { pg8::EpiNull EN; pg8::gemm_phase<pg8::EpiNull, pg8::StaticOrder, PG8_ALIGN, PG8_SP2, false, true, 0, W_LIN>(F.lds + RING_OFF, g8, S, EN, F.wave); __syncthreads(); }
                pg8::gemm_phase<pg8::EpiBf16<2, false, H_BLK>, pg8::StaticOrder, PG8_ALIGN, PG8_SP2, false, true, 0, W_LIN>(F.lds + RING_OFF, g8, S, E, F.wave);
            } else if (FP8_DOWN1 && l == 1) {
                pg8::EpiBf16<3, false, H_BLK> E{HB, FF, (const LAS float*)(F.lds + RSL_OFF), 1.0f, nullptr};
                pg8::gemm_phase<pg8::EpiBf16<3, false, H_BLK>, pg8::StaticOrder, PG8_ALIGN, PG8_SP2, false, false, 0, W_LIN>(F.lds + RING_OFF, g, S, E, F.wave);
            } else {
            pg8::EpiBf16<2, false, H_BLK> E{HB, FF, (const LAS float*)(F.lds + RSL_OFF), 1.0f, nullptr};
            if (PROBE_DUP == 5 && l == 0) { pg8::gemm_phase<pg8::EpiBf16<2, false, H_BLK>, pg8::StaticOrder, PG8_ALIGN, PG8_SP2, false, false, 0, W_LIN>(F.lds + RING_OFF, g, S, E, F.wave); __syncthreads(); }
            if (PROBE_DUP == 9 && l == 0) { pg8::SameTileOrder S2; S2.init(M, FF, F.G, (int)blockIdx.x); pg8::gemm_phase<pg8::EpiBf16<2, false, H_BLK>, pg8::SameTileOrder, PG8_ALIGN, PG8_SP2, false, false, 0, W_LIN>(F.lds + RING_OFF, g, S2, E, F.wave); __syncthreads(); }
            pg8::gemm_phase<pg8::EpiBf16<2, false, H_BLK>, pg8::StaticOrder, PG8_ALIGN, PG8_SP2, false, false, 0, W_LIN>(F.lds + RING_OFF, g, S, E, F.wave);
            }
            if (BOTH(pb + 4)) GRID_BAR();
        }
        if (!split && IN(pb + 5)) {
            pg8::StaticOrder S; S.init(M, D, F.G, (int)blockIdx.x);
            GEMM_SKEW(SKEW_DN);
            if (FP8_DOWN1 && l == 1) {
                pg8::Gemm g{HB, Wdn, M, D, FF / 2};
                pg8::EpiBf16<0, false, Y_BLK> E{YB, D, nullptr, 1.0f / (pg8::FP8_HSCALE * pg8::FP8_WSCALE), nullptr};
                pg8::gemm_phase<pg8::EpiBf16<0, false, Y_BLK>, pg8::StaticOrder, PG8_ALIGN, PG8_SP2, true, false, H_BLK == 2 ? -1 : H_BLK ? 256 : 0, W_LIN>(F.lds + RING_OFF, g, S, E, F.wave);
            } else {
            pg8::Gemm g{HB, Wdn, M, D, FF};
            pg8::EpiBf16<0, false, Y_BLK> E{YB, D, nullptr, 1.0f, nullptr};
            if (PROBE_DUP == 7 && l == 0) { pg8::gemm_phase<pg8::EpiBf16<0, false, Y_BLK>, pg8::StaticOrder, PG8_ALIGN, PG8_SP2, false, false, H_BLK == 2 ? -1 : H_BLK ? 512 : 0, W_LIN>(F.lds + RING_OFF, g, S, E, F.wave); __syncthreads(); }
            pg8::gemm_phase<pg8::EpiBf16<0, false, Y_BLK>, pg8::StaticOrder, PG8_ALIGN, PG8_SP2, false, false, H_BLK == 2 ? -1 : H_BLK ? 512 : 0, W_LIN>(F.lds + RING_OFF, g, S, E, F.wave);
            }
            if (BOTH(pb + 5)) GRID_BAR();
        }
        if (IN(pb + 6)) {
            if (l == 0) thin_phase<false>(F, YB, nullptr, XN, RS, nullptr, n_mlp_post);
            else        thin_phase<true>(F, YB, nullptr, XN, nullptr, out, n_mlp_post + D);
            if (BOTH(pb + 6)) GRID_BAR();
        }
}
#undef IN
#undef BOTH
#undef GRID_BAR
#undef GEMM_SKEW
struct Args { const float* in[14]; float* out; unsigned char* ws; int ph_lo, ph_hi; };
__global__ void __launch_bounds__(NWAVES * 64, 2) yoco_fwd(Args args) {
    extern __shared__ __attribute__((aligned(16))) unsigned char lds[];
    Frame F;
    F.lds = (LAS unsigned char*)lds;
    F.MISC = (volatile LAS unsigned*)(F.lds + MISC_OFF);
    F.wave = __builtin_amdgcn_readfirstlane((int)threadIdx.x >> 6); F.tid = pg8::wave_tid(F.wave); F.lane = F.tid & 63;
    F.G = gridDim.x; { const int bx = blockIdx.x; F.vcu = (F.G % 8 == 0) ? (bx % 8) * (F.G / 8) + bx / 8 : bx; }
    unsigned char* ws = args.ws;
    F.ctl = (gu32*)(ws + WS_CTL);
    for (int u = F.tid; u < (LDS_BYTES - LDSCTL_OFF) / 4; u += NWAVES * 64) ((LAS unsigned*)(F.lds + LDSCTL_OFF))[u] = 0u;
    __syncthreads();
    XcdBarrier bar; bar.bar = (unsigned*)(F.ctl + CW_BAR); bar.x = 0; bar.st = nullptr; bar.w = (unsigned)F.wave;
    if (N_LAUNCHES == 1) bar = xcd_barrier_post((unsigned*)(F.ctl + CW_BAR), F.MISC + 8, (unsigned)F.wave);
#define GRID_BAR() do { if (N_LAUNCHES == 1) xcd_barrier(bar); } while (0)
    const int lo = args.ph_lo, hi = args.ph_hi;
#define IN(k) (lo <= (k) && (k) < hi)
#define BOTH(k) (IN(k) && IN((k) + 1))

    const float* x = args.in[0]; const float* w_qkv_a = args.in[1]; const float* sinks_a = args.in[2]; const float* w_o_a = args.in[3]; const float* kv_norm = args.in[4];
    const float* w_kv = args.in[5]; const float* w_q_b = args.in[6]; const float* w_o_b = args.in[7]; const float* n_attn_pre = args.in[8]; const float* n_attn_post = args.in[9];
    const float* n_mlp_pre = args.in[10]; const float* n_mlp_post = args.in[11]; const float* w_up = args.in[12]; const float* w_down = args.in[13];
    bf16* Wb = (bf16*)(ws + WS_W);
    bf16* QO = (bf16*)(ws + WS_QO); bf16* HB = (bf16*)(ws + WS_H); bf16* XN = (bf16*)(ws + WS_XN); bf16* KB = (bf16*)(ws + WS_K); bf16* VT = (bf16*)(ws + WS_VT);
    float* KMEAN = (float*)(ws + CTL_KMEAN); float* RS = (float*)(ws + WS_RS);
    float* out = args.out;

    const WSrc W{(unsigned*)(ws + CTL_CMAX), w_qkv_a, w_o_a, kv_norm, w_kv, w_q_b, w_o_b, n_attn_pre, n_mlp_pre, w_up, w_down};
    if (IN(0)) {
      for (int rep = 0; rep < (PROBE_DUP == 1 ? 2 : 1); ++rep) {
        const int gw = F.vcu * NWAVES + F.wave, NGW = F.G * NWAVES;
        if (I8_UP1) convert_weights(W, Wb, CV_ALL + (SLOT_MOVE ? CV_UPS : 0), CV_ALL + (I8_UP0 ? 2 : 1) * CV_UPS, gw, NGW, F.lds + RING_OFF, F.wave, F.lane);
        convert_weights(W, Wb, 0, CV_P0, gw, NGW, F.lds + RING_OFF, F.wave, F.lane, CV_QKV + CV_O + CV_UP, (SLOT_DN0 && !SLOT_MOVE) ? CV_DN : 0);
        { const int ln_ = pg8::lane_now(); for (int m = gw; m < M; m += NGW) rms_row_to_bf16(x + (size_t)m * D, XN + (size_t)m * D, RS + m, ln_); }
        VM_WAIT(); __syncthreads();
      }
        if (BOTH(0)) GRID_BAR();
    }
    { LayerCtx C{&W, RS, x, out, sinks_a, n_attn_post, n_mlp_post, Wb, QO, HB, XN, KB, VT, KMEAN, lo, hi};
      layer_phases<0>(F, bar, C);
      layer_phases<1>(F, bar, C); }
#undef IN
#undef BOTH
#undef GRID_BAR
}

extern "C" void kernel_launch(void* const* d_in, const int* in_sizes, int n_in, void* d_out, int out_size, void* d_ws, size_t ws_size, hipStream_t stream) {
    static int grid = 0;
    if (grid == 0) {
        if (n_in != 14 || in_sizes[0] != M * D || out_size != M * D || ws_size < WS_END) { fprintf(stderr, "kernel_launch: unexpected shapes / workspace (n_in %d, in0 %d, out %d, ws %zu < %zu)\n", n_in, n_in > 0 ? in_sizes[0] : -1, out_size, ws_size, (size_t)WS_END); grid = -1; return; }
        int dev = 0, cus = 0, per_cu = 0;
        if (hipGetDevice(&dev) != hipSuccess || hipDeviceGetAttribute(&cus, hipDeviceAttributeMultiprocessorCount, dev) != hipSuccess) { grid = -1; return; }
        if (hipFuncSetAttribute((const void*)yoco_fwd, hipFuncAttributeMaxDynamicSharedMemorySize, LDS_BYTES) != hipSuccess) { fprintf(stderr, "kernel_launch: hipFuncSetAttribute failed\n"); grid = -1; return; }
        if (hipOccupancyMaxActiveBlocksPerMultiprocessor(&per_cu, (const void*)yoco_fwd, NWAVES * 64, LDS_BYTES) != hipSuccess || per_cu < 1) { fprintf(stderr, "kernel_launch: occupancy query reports %d workgroups per CU\n", per_cu); }
        (void)hipGetLastError();
        grid = cus;
    }
    if (grid < 0) return;
    if (hipMemsetAsync((char*)d_ws + WS_CTL, 0, CTL_ZERO_BYTES, stream) != hipSuccess) return;
    Args a{};
    for (int i = 0; i < 14; ++i) a.in[i] = (const float*)d_in[i];
    a.out = (float*)d_out; a.ws = (unsigned char*)d_ws;
    if (N_LAUNCHES == 1) { a.ph_lo = 0; a.ph_hi = N_PHASES; hipLaunchKernelGGL(yoco_fwd, dim3(grid), dim3(NWAVES * 64), LDS_BYTES, stream, a); }
    else for (int p = 0; p < N_PHASES; ++p) { a.ph_lo = p; a.ph_hi = p + 1; hipLaunchKernelGGL(yoco_fwd, dim3(grid), dim3(NWAVES * 64), LDS_BYTES, stream, a); }
}
```
